# Optimizing an MI355X kernel written in HIP

```python
import jax, jax.numpy as jnp
from jax import lax
import numpy as np

D_MODEL = 1024
BATCH = 16
SEQ = 2048
DEPTH = 1

CHUNK = 64
Q_BLOCK = 128
ROPE_THETA = 10000.0
EPS = 1e-6
GN_EPS = 1e-5
NEG_BIG = -1e30
A_HEADS = 8
A_HEAD_DIM = 64
IDX_HEADS = 8
IDX_DIM = 64
TOPK_MAX = 256
A_WIDTH = A_HEADS * A_HEAD_DIM
R_HEADS = 4
R_QK_DIM = 128
R_V_DIM = 256
R_WIDTH = R_HEADS * R_V_DIM
D_FF = 2816
PLE_DIM = 256
IN_SPLITS = (
    A_HEADS * A_HEAD_DIM,
    A_HEAD_DIM,
    A_HEAD_DIM,
    IDX_HEADS * IDX_DIM,
    IDX_DIM,
    IDX_HEADS,
    R_HEADS * R_QK_DIM,
    R_HEADS * R_QK_DIM,
    R_HEADS * R_V_DIM,
    R_HEADS * R_V_DIM,
    D_MODEL,
    D_MODEL,
)
IN_WIDTH = sum(IN_SPLITS)

kernel_name = 'hybrid_dsa_retention_macaron'


def rms_norm(x, g):
    xf = x.astype(jnp.float32)
    y = xf * lax.rsqrt(jnp.mean(xf * xf, axis=-1, keepdims=True) + EPS)
    return (y * g.astype(jnp.float32)).astype(x.dtype)


def swiglu(x, w_gate, w_up, w_down):
    return (jax.nn.silu(x @ w_gate) * (x @ w_up)) @ w_down


def rope(t, pos):
    half = t.shape[-1] // 2
    inv = ROPE_THETA ** (-jnp.arange(half, dtype=jnp.float32) / half)
    ang = pos.astype(jnp.float32)[..., None] * inv
    cos = jnp.cos(ang)[:, :, None, :]
    sin = jnp.sin(ang)[:, :, None, :]
    t1 = t[..., :half].astype(jnp.float32)
    t2 = t[..., half:].astype(jnp.float32)
    return jnp.concatenate([t1 * cos - t2 * sin, t2 * cos + t1 * sin], axis=-1).astype(t.dtype)


def dsa_attention(q, k, v, q_idx, k_idx, w_idx, n_sel):
    b, s = q.shape[0], q.shape[1]
    nb = s // Q_BLOCK
    key_pos = jnp.arange(s)
    k_idx32 = k_idx.astype(jnp.float32)

    def to_blocks(t):
        return jnp.moveaxis(t.reshape((b, nb, Q_BLOCK) + t.shape[2:]), 1, 0)

    def one_block(args):
        qb, qib, wb, blk = args
        qpos = blk * Q_BLOCK + jnp.arange(Q_BLOCK)
        visible_end = (qpos // CHUNK + 1) * CHUNK
        admissible = key_pos[None, :] < visible_end[:, None]
        rel = jax.nn.relu(jnp.einsum('bqhd,bsd->bqhs', qib.astype(jnp.float32), k_idx32))
        score = jnp.einsum('bqhs,bqh->bqs', rel, wb.astype(jnp.float32))
        score = jnp.where(admissible[None], score, NEG_BIG)
        top_val, top_pos = lax.top_k(score, n_sel)
        valid = top_val > 0.5 * NEG_BIG
        k_sel = jax.vmap(lambda kb, ib: kb[ib])(k, top_pos)
        v_sel = jax.vmap(lambda vb, ib: vb[ib])(v, top_pos)
        logits = jnp.einsum('bqhd,bqkd->bqhk', qb, k_sel).astype(jnp.float32) * (A_HEAD_DIM ** -0.5)
        logits = jnp.where(valid[:, :, None, :], logits, NEG_BIG)
        probs = jax.nn.softmax(logits, axis=-1).astype(v.dtype)
        return jnp.einsum('bqhk,bqkd->bqhd', probs, v_sel)

    out = lax.map(one_block, (to_blocks(q), to_blocks(q_idx), to_blocks(w_idx), jnp.arange(nb)))
    return jnp.moveaxis(out, 0, 1).reshape(b, s, -1)


def retention(q, k, v):
    b, s, h, dk = q.shape
    dv = v.shape[-1]
    n = s // CHUNK
    log_gamma = jnp.log1p(-jnp.exp2(-5.0 - jnp.arange(h, dtype=jnp.float32)))
    idx = jnp.arange(CHUNK, dtype=jnp.float32)
    decay_intra = jnp.exp(log_gamma[:, None, None] * jnp.abs(idx[:, None] - idx[None, :]))
    decay_q = jnp.exp(log_gamma[None, :] * (idx[:, None] + 1.0))
    decay_k = jnp.exp(log_gamma[None, :] * (CHUNK - 1.0 - idx[:, None]))
    decay_chunk = jnp.exp(log_gamma * CHUNK)
    qc = q.reshape(b, n, CHUNK, h, dk)
    kc = (k * (dk ** -0.5)).reshape(b, n, CHUNK, h, dk)
    vc = v.reshape(b, n, CHUNK, h, dv)
    scores = jnp.einsum('bnihd,bnjhd->bnhij', qc, kc) * decay_intra
    y_intra = jnp.einsum('bnhij,bnjhe->bnihe', scores, vc)
    kv = jnp.einsum('bnjhd,bnjhe,jh->nbhde', kc, vc, decay_k)

    def step(state, kv_n):
        return decay_chunk[None, :, None, None] * state + kv_n, state

    _, prev = lax.scan(step, jnp.zeros((b, h, dk, dv), jnp.float32), kv)
    y_cross = jnp.einsum('bnihd,nbhde->bnihe', qc, prev) * decay_q[None, None, :, :, None]
    return (y_intra + y_cross).reshape(b, s, h, dv)


def group_norm_heads(y, g):
    mean = jnp.mean(y, axis=-1, keepdims=True)
    var = jnp.mean(jnp.square(y - mean), axis=-1, keepdims=True)
    yn = (y - mean) * lax.rsqrt(var + GN_EPS)
    return yn.reshape(y.shape[0], y.shape[1], -1) * g.astype(jnp.float32)


def setup_inputs(seed: int = 0) -> dict:
    key = jax.random.key(seed)
    ks = jax.random.split(key, 24)
    f32 = jnp.float32

    def w(k, shape, fan_in, scale=1.0):
        return jax.random.normal(k, shape, f32) * (scale * fan_in ** -0.5)

    def gain(k, shape):
        return 1.0 + 0.05 * jax.random.normal(k, shape, f32)

    offsets = jax.random.randint(ks[2], (BATCH, 1), 0, 4096)
    positions = (offsets + jnp.arange(SEQ)[None, :]).astype(jnp.int32)
    return {
        'x': jax.random.normal(ks[0], (BATCH, SEQ, D_MODEL), f32),
        'p': jax.random.normal(ks[1], (DEPTH, BATCH, SEQ, PLE_DIM), f32),
        'positions': positions,
        'ffn1_norm': gain(ks[3], (DEPTH, D_MODEL)),
        'ffn1_w_gate': w(ks[4], (DEPTH, D_MODEL, D_FF), D_MODEL),
        'ffn1_w_up': w(ks[5], (DEPTH, D_MODEL, D_FF), D_MODEL),
        'ffn1_w_down': w(ks[6], (DEPTH, D_FF, D_MODEL), D_FF, 0.5),
        'mix_norm': gain(ks[7], (DEPTH, D_MODEL)),
        'w_in': w(ks[8], (DEPTH, D_MODEL, IN_WIDTH), D_MODEL),
        'ret_gn': gain(ks[9], (DEPTH, R_WIDTH)),
        'w_branch_a': w(ks[10], (DEPTH, A_WIDTH, D_MODEL), A_WIDTH),
        'w_branch_b': w(ks[11], (DEPTH, R_WIDTH, D_MODEL), R_WIDTH),
        'w_out': w(ks[12], (DEPTH, D_MODEL, D_MODEL), D_MODEL, 0.5),
        'ffn2_norm': gain(ks[13], (DEPTH, D_MODEL)),
        'ffn2_w_gate': w(ks[14], (DEPTH, D_MODEL, D_FF), D_MODEL),
        'ffn2_w_up': w(ks[15], (DEPTH, D_MODEL, D_FF), D_MODEL),
        'ffn2_w_down': w(ks[16], (DEPTH, D_FF, D_MODEL), D_FF, 0.5),
        'ple_norm': gain(ks[17], (DEPTH, D_MODEL)),
        'w_ple_gate': w(ks[18], (DEPTH, D_MODEL, D_MODEL), D_MODEL),
        'w_ple_proj': w(ks[19], (DEPTH, PLE_DIM, D_MODEL), PLE_DIM, 0.5),
        'final_norm': gain(ks[20], (D_MODEL,)),
    }


def reference(x, p, positions, ffn1_norm, ffn1_w_gate, ffn1_w_up, ffn1_w_down,
              mix_norm, w_in, ret_gn, w_branch_a, w_branch_b, w_out,
              ffn2_norm, ffn2_w_gate, ffn2_w_up, ffn2_w_down,
              ple_norm, w_ple_gate, w_ple_proj, final_norm):
    b, s, _ = x.shape
    n_sel = min(TOPK_MAX, s // 4)
    split_points = []
    acc = 0
    for sz in IN_SPLITS[:-1]:
        acc += sz
        split_points.append(acc)

    h = x
    for i in range(DEPTH):
        h = h + 0.5 * swiglu(rms_norm(h, ffn1_norm[i]), ffn1_w_gate[i], ffn1_w_up[i], ffn1_w_down[i])

        u = rms_norm(h, mix_norm[i])
        z = u @ w_in[i]
        (aq, ak, av, iq, ik, iw, rq, rk, rv, rg, ga, gb) = jnp.split(z, split_points, axis=-1)

        aq = rope(aq.reshape(b, s, A_HEADS, A_HEAD_DIM), positions)
        ak = rope(ak[:, :, None, :], positions)[:, :, 0, :]
        iq = rope(iq.reshape(b, s, IDX_HEADS, IDX_DIM), positions) * (IDX_DIM ** -0.5)
        ik = rope(ik[:, :, None, :], positions)[:, :, 0, :]
        iw = iw * (IDX_HEADS ** -0.5)
        y_a = dsa_attention(aq, ak, av, iq, ik, iw, n_sel)

        rq = rope(rq.reshape(b, s, R_HEADS, R_QK_DIM), positions).astype(jnp.float32)
        rk = rope(rk.reshape(b, s, R_HEADS, R_QK_DIM), positions).astype(jnp.float32)
        rv = rv.reshape(b, s, R_HEADS, R_V_DIM).astype(jnp.float32)
        y_r = group_norm_heads(retention(rq, rk, rv), ret_gn[i]).astype(x.dtype) * jax.nn.silu(rg)

        merged = jax.nn.sigmoid(ga) * (y_a @ w_branch_a[i]) + jax.nn.sigmoid(gb) * (y_r @ w_branch_b[i])
        h = h + merged @ w_out[i]

        h = h + 0.5 * swiglu(rms_norm(h, ffn2_norm[i]), ffn2_w_gate[i], ffn2_w_up[i], ffn2_w_down[i])

        gate = jax.nn.sigmoid(rms_norm(h, ple_norm[i]) @ w_ple_gate[i])
        h = h + gate * (p[i] @ w_ple_proj[i])

    return rms_norm(h, final_norm)
```

```cpp
#include <hip/hip_runtime.h>
#include <cstdint>
#include <cstdio>

typedef unsigned short bf16_t;
typedef short bf16x8 __attribute__((ext_vector_type(8)));
typedef float f32x4 __attribute__((ext_vector_type(4)));
typedef float f32x16 __attribute__((ext_vector_type(16)));
typedef unsigned u32x4 __attribute__((ext_vector_type(4)));

constexpr int M = 32768, D = 1024, FF = 2816, SEQ = 2048, NBATCH = 16, INW = 6344;
constexpr float EPS = 1e-6f, GN_EPS = 1e-5f;

constexpr size_t MiB = 1u << 20;
constexpr size_t WS_CTL = 0;
constexpr size_t WS_WGU1 = 1 * MiB;
constexpr size_t WS_WD1 = WS_WGU1 + 11 * MiB;
constexpr size_t WS_WIN = WS_WD1 + 11 * MiB / 2;
constexpr size_t WS_WGATE = WS_WIN + 17 * MiB / 2;
constexpr size_t WS_WAB = WS_WGATE + 4 * MiB;
constexpr size_t WS_WOUT = WS_WAB + 3 * MiB;
constexpr size_t WS_WGU2 = WS_WOUT + 2 * MiB;
constexpr size_t WS_WD2 = WS_WGU2 + 11 * MiB;
constexpr size_t WS_WPG = WS_WD2 + 11 * MiB / 2;
constexpr size_t WS_WPP = WS_WPG + 2 * MiB;
constexpr size_t WS_CS64 = 56 * MiB;
constexpr size_t WS_CS32 = 72 * MiB;
constexpr size_t WS_SS0 = 80 * MiB;
constexpr size_t WS_SS1 = 82 * MiB;
constexpr size_t WS_HB = 84 * MiB;
constexpr size_t WS_PB = 148 * MiB;
constexpr size_t WS_R1 = 164 * MiB;
constexpr size_t WS_HID = WS_R1;
constexpr size_t WS_IQ = WS_R1;
constexpr size_t WS_RQ = WS_R1 + 32 * MiB;
constexpr size_t WS_RK = WS_R1 + 64 * MiB;
constexpr size_t WS_AK = WS_R1 + 96 * MiB;
constexpr size_t WS_AV = WS_R1 + 100 * MiB;
constexpr size_t WS_IK = WS_R1 + 104 * MiB;
constexpr size_t WS_IW = WS_R1 + 108 * MiB;
constexpr size_t WS_MASK = WS_R1 + 109 * MiB;
constexpr size_t WS_GA = WS_R1;
constexpr size_t WS_MERGED = WS_R1 + 64 * MiB;
constexpr size_t WS_PP = WS_R1;
constexpr size_t WS_R2 = 340 * MiB;
constexpr size_t WS_YB = WS_R2;
constexpr size_t WS_RV = WS_R2 + 96 * MiB;
constexpr size_t WS_GB = WS_RV;
constexpr size_t WS_END = 500 * MiB;
static_assert(WS_WPP + MiB / 2 <= WS_CS64 && WS_MASK + 8 * MiB <= WS_R1 + 176 * MiB && WS_R1 + 176 * MiB == WS_R2 && WS_RV + 64 * MiB == WS_END, "ws map");

__device__ __forceinline__ float bf2f(bf16_t b) { return __uint_as_float(((unsigned)b) << 16); }
__device__ __forceinline__ bf16_t f2bf(float f) { unsigned u = __float_as_uint(f); return (bf16_t)((u + 0x7fffu + ((u >> 16) & 1u)) >> 16); }
__device__ __forceinline__ float silu_f(float x) { return x / (1.f + __expf(-x)); }
__device__ __forceinline__ float sigm_f(float x) { return 1.f / (1.f + __expf(-x)); }
__device__ __forceinline__ float wave_sum(float v) {
#pragma unroll
    for (int o = 1; o < 64; o <<= 1) v += __shfl_xor(v, o);
    return v;
}
__device__ __forceinline__ float wave_max(float v) {
#pragma unroll
    for (int o = 1; o < 64; o <<= 1) v = fmaxf(v, __shfl_xor(v, o));
    return v;
}

__host__ __device__ __forceinline__ int win_src(int t, int c, float& sc) {
    sc = 1.f;
    const int hi = c >> 7, cc = c & 127;
    if (t < 2) { sc = 0.125f; const int head = 4 * t + (cc >> 5), d = cc & 31; return head * 64 + hi * 32 + d; }
    if (t == 2) {
        if (!hi) { if (cc < 32) return 512 + cc; if (cc < 64) return 1152 + (cc - 32); if (cc < 96) return 576 + (cc - 64); return 576 + 32 + (cc - 96); }
        if (cc < 32) return 512 + 32 + cc; if (cc < 64) return 1152 + 32 + (cc - 32); if (cc < 72) { sc = 0.35355339059327373f; return 1216 + (cc - 64); } return -1;
    }
    if (t < 5) { sc = 0.125f; const int head = 4 * (t - 3) + (cc >> 5), d = cc & 31; return 640 + head * 64 + hi * 32 + d; }
    if (t < 7) { const int head = 2 * (t - 5) + (cc >> 6), d = cc & 63; return 1224 + head * 128 + hi * 64 + d; }
    if (t < 9) { sc = 0.08838834764831845f; const int head = 2 * (t - 7) + (cc >> 6), d = cc & 63; return 1736 + head * 128 + hi * 64 + d; }
    if (t < 13) return 2248 + 256 * (t - 9) + c;
    return 3272 + 256 * (t - 13) + c;
}

struct SrcPlain { const float* W; int ldw; const float* gk; float scale;
    __device__ float operator()(int n, int k) const { float v = W[(size_t)k * ldw + n]; if (gk) v *= gk[k]; return v * scale; } };
struct SrcGU { const float* Wg; const float* Wu; const float* gk;
    __device__ float operator()(int n, int k) const { const int t = n >> 8, c = n & 255; const float* W = c < 128 ? Wg : Wu; return W[(size_t)k * FF + t * 128 + (c & 127)] * gk[k]; } };
struct SrcWin { const float* W; const float* gk;
    __device__ float operator()(int n, int k) const { float sc; const int col = win_src(n >> 8, n & 255, sc); if (col < 0) return 0.f; return W[(size_t)k * INW + col] * gk[k] * sc; } };

template <class F> __global__ void __launch_bounds__(256) prep_wt(F f, bf16_t* out, int ldo) {
    __shared__ float tile[32][33];
    const int n0 = blockIdx.x * 32, k0 = blockIdx.y * 32, tx = threadIdx.x, ty = threadIdx.y;
    for (int i = ty; i < 32; i += 8) tile[i][tx] = f(n0 + tx, k0 + i);
    __syncthreads();
    for (int i = ty; i < 32; i += 8) out[(size_t)(n0 + i) * ldo + k0 + tx] = f2bf(tile[tx][i]);
}

__global__ void __launch_bounds__(256) prep_x(const float* x, bf16_t* hb, float* ss) {
    __shared__ float red[4];
    const int row = blockIdx.x, tid = threadIdx.x;
    const f32x4 v = *(const f32x4*)(x + (size_t)row * D + tid * 4);
    uint2 o; o.x = (unsigned)f2bf(v.x) | ((unsigned)f2bf(v.y) << 16); o.y = (unsigned)f2bf(v.z) | ((unsigned)f2bf(v.w) << 16);
    *(uint2*)(hb + (size_t)row * D + tid * 4) = o;
    float s = wave_sum(v.x * v.x + v.y * v.y + v.z * v.z + v.w * v.w);
    if ((tid & 63) == 0) red[tid >> 6] = s;
    __syncthreads();
    if (tid < 16) ss[(size_t)row * 16 + tid] = tid == 0 ? (red[0] + red[1]) + (red[2] + red[3]) : 0.f;
}
__global__ void __launch_bounds__(256) k_rowss(const float* h, float* ss) {
    __shared__ float red[4];
    const int row = blockIdx.x, tid = threadIdx.x;
    const f32x4 v = *(const f32x4*)(h + (size_t)row * D + tid * 4);
    float s = wave_sum(v.x * v.x + v.y * v.y + v.z * v.z + v.w * v.w);
    if ((tid & 63) == 0) red[tid >> 6] = s;
    __syncthreads();
    if (tid < 16) ss[(size_t)row * 16 + tid] = tid == 0 ? (red[0] + red[1]) + (red[2] + red[3]) : 0.f;
}
__global__ void __launch_bounds__(256) prep_p(const float* p, bf16_t* pb) {
    const size_t i = ((size_t)blockIdx.x * 256 + threadIdx.x) * 4;
    const f32x4 v = *(const f32x4*)(p + i);
    uint2 o; o.x = (unsigned)f2bf(v.x) | ((unsigned)f2bf(v.y) << 16); o.y = (unsigned)f2bf(v.z) | ((unsigned)f2bf(v.w) << 16);
    *(uint2*)(pb + i) = o;
}
__global__ void __launch_bounds__(256) prep_rope(const int* pos, float* cs64, float* cs32) {
    const int i = blockIdx.x * 256 + threadIdx.x, tok = i >> 6, k = i & 63;
    const float inv = powf(10000.f, -(float)k / 64.f);
    const float ang = (float)pos[tok] * inv;
    const float c = cosf(ang), s = sinf(ang);
    cs64[(size_t)tok * 128 + k] = c; cs64[(size_t)tok * 128 + 64 + k] = s;
    if ((k & 1) == 0) { cs32[(size_t)tok * 64 + (k >> 1)] = c; cs32[(size_t)tok * 64 + 32 + (k >> 1)] = s; }
}

__device__ __forceinline__ float row_rstd(const float* ss, int row) {
    const f32x4* p = (const f32x4*)(ss + (size_t)row * 16);
    const f32x4 a = p[0], b = p[1], c = p[2], d = p[3];
    const float s = ((a.x + a.y) + (a.z + a.w)) + ((b.x + b.y) + (b.z + b.w)) + ((c.x + c.y) + (c.z + c.w)) + ((d.x + d.y) + (d.z + d.w));
    return rsqrtf(s * (1.f / 1024.f) + EPS);
}
struct EGU {
    static constexpr bool HAS_MID = false; static constexpr int MIDK = 0;
    const float* ss; bf16_t* hid;
    __device__ float rowscale(int row) const { return row_rstd(ss, row); }
    __device__ void elem(int row, int t, int c, float v0, float v1, float rs) const { hid[(size_t)row * FF + t * 128 + c] = f2bf(silu_f(v0 * rs) * (v1 * rs)); }
    __device__ void mid(int, int, int, float&, float&) const {}
};
struct ERES {
    static constexpr bool HAS_MID = false; static constexpr int MIDK = 0;
    const float* res; float* H; bf16_t* hb; float sc;
    __device__ float rowscale(int) const { return 1.f; }
    __device__ void elem(int row, int t, int c, float v0, float v1, float) const {
        const size_t i0 = (size_t)row * D + t * 256 + c, i1 = i0 + 128;
        const float h0 = res[i0] + sc * v0, h1 = res[i1] + sc * v1;
        H[i0] = h0; H[i1] = h1; hb[i0] = f2bf(h0); hb[i1] = f2bf(h1);
    }
    __device__ void mid(int, int, int, float&, float&) const {}
};
struct EWIN {
    static constexpr bool HAS_MID = false; static constexpr int MIDK = 0;
    const float* ss; const float* cs64; const float* cs32;
    bf16_t *yb, *ak, *av, *iq, *ik, *rq, *rk, *rv; float* iw;
    __device__ float rowscale(int row) const { return row_rstd(ss, row); }
    __device__ void elem(int row, int t, int c, float v0, float v1, float rs) const {
        const float a = v0 * rs, b = v1 * rs;
        if (t < 2 || t == 3 || t == 4) {
            const int tt = t < 2 ? t : t - 3, head = 4 * tt + (c >> 5), d = c & 31;
            const float cs = cs32[(size_t)row * 64 + d], sn = cs32[(size_t)row * 64 + 32 + d];
            const float o1 = a * cs - b * sn, o2 = b * cs + a * sn;
            if (t < 2) { bf16_t* o = yb + (size_t)row * 1536 + head * 64 + d; o[0] = f2bf(o1); o[32] = f2bf(o2); }
            else { bf16_t* o = iq + (size_t)row * 512 + head * 64 + d; o[0] = f2bf(o1); o[32] = f2bf(o2); }
        } else if (t == 2) {
            if (c < 64) {
                const int d = c & 31;
                const float cs = cs32[(size_t)row * 64 + d], sn = cs32[(size_t)row * 64 + 32 + d];
                const float o1 = a * cs - b * sn, o2 = b * cs + a * sn;
                bf16_t* o = (c < 32 ? ak : ik) + (size_t)row * 64 + d; o[0] = f2bf(o1); o[32] = f2bf(o2);
            } else {
                av[(size_t)row * 64 + (c - 64)] = f2bf(a);
                if (c < 72) iw[(size_t)row * 8 + (c - 64)] = b;
            }
        } else if (t < 9) {
            const int tt = t < 7 ? t - 5 : t - 7, head = 2 * tt + (c >> 6), d = c & 63;
            const float cs = cs64[(size_t)row * 128 + d], sn = cs64[(size_t)row * 128 + 64 + d];
            const float o1 = a * cs - b * sn, o2 = b * cs + a * sn;
            bf16_t* o = (t < 7 ? rq : rk) + (size_t)row * 512 + head * 128 + d; o[0] = f2bf(o1); o[64] = f2bf(o2);
        } else if (t < 13) {
            bf16_t* o = rv + (size_t)row * 1024 + 256 * (t - 9) + c; o[0] = f2bf(a); o[128] = f2bf(b);
        } else {
            bf16_t* o = yb + (size_t)row * 1536 + 512 + 256 * (t - 13) + c; o[0] = f2bf(silu_f(a)); o[128] = f2bf(silu_f(b));
        }
    }
    __device__ void mid(int, int, int, float&, float&) const {}
};
struct EGATE {
    static constexpr bool HAS_MID = false; static constexpr int MIDK = 0;
    const float* ss; bf16_t *ga, *gb;
    __device__ float rowscale(int row) const { return row_rstd(ss, row); }
    __device__ void elem(int row, int t, int c, float v0, float v1, float rs) const {
        bf16_t* o = (t < 4 ? ga : gb) + (size_t)row * D + 256 * (t & 3) + c; o[0] = f2bf(sigm_f(v0 * rs)); o[128] = f2bf(sigm_f(v1 * rs));
    }
    __device__ void mid(int, int, int, float&, float&) const {}
};
struct EBR {
    static constexpr bool HAS_MID = true; static constexpr int MIDK = 512;
    const bf16_t *ga, *gb; bf16_t* merged;
    __device__ float rowscale(int) const { return 1.f; }
    __device__ void mid(int row, int t, int c, float& v0, float& v1) const {
        const size_t i0 = (size_t)row * D + 256 * t + c, i1 = i0 + 128;
        v0 *= bf2f(ga[i0]) / bf2f(gb[i0]); v1 *= bf2f(ga[i1]) / bf2f(gb[i1]);
    }
    __device__ void elem(int row, int t, int c, float v0, float v1, float) const {
        const size_t i0 = (size_t)row * D + 256 * t + c, i1 = i0 + 128;
        merged[i0] = f2bf(v0 * bf2f(gb[i0])); merged[i1] = f2bf(v1 * bf2f(gb[i1]));
    }
};
struct EPP {
    static constexpr bool HAS_MID = false; static constexpr int MIDK = 0;
    float* pp;
    __device__ float rowscale(int) const { return 1.f; }
    __device__ void elem(int row, int t, int c, float v0, float v1, float) const { const size_t i0 = (size_t)row * D + 256 * t + c; pp[i0] = v0; pp[i0 + 128] = v1; }
    __device__ void mid(int, int, int, float&, float&) const {}
};
struct EPLE {
    static constexpr bool HAS_MID = false; static constexpr int MIDK = 0;
    const float* ss; const float* pp; float* H;
    __device__ float rowscale(int row) const { return row_rstd(ss, row); }
    __device__ void elem(int row, int t, int c, float v0, float v1, float rs) const {
        const size_t i0 = (size_t)row * D + 256 * t + c, i1 = i0 + 128;
        H[i0] = H[i0] + sigm_f(v0 * rs) * pp[i0]; H[i1] = H[i1] + sigm_f(v1 * rs) * pp[i1];
    }
    __device__ void mid(int, int, int, float&, float&) const {}
};

template <class Epi> __global__ void __launch_bounds__(256) ngemm(const bf16_t* A, int lda, const bf16_t* Bt, int ldb, int K, Epi E) {
    const int wid = threadIdx.x >> 6, lane = threadIdx.x & 63, r = lane & 31, h = lane >> 5;
    const int row0 = blockIdx.x * 32, t = blockIdx.y;
    const bf16_t* ap = A + (size_t)(row0 + r) * lda + 8 * h;
    const bf16_t* b0 = Bt + (size_t)(t * 256 + wid * 32 + r) * ldb + 8 * h;
    const bf16_t* b1 = b0 + (size_t)128 * ldb;
    f32x16 c0, c1;
#pragma unroll
    for (int i = 0; i < 16; ++i) { c0[i] = 0.f; c1[i] = 0.f; }
    for (int k = 0; k < K; k += 16) {
        if (Epi::HAS_MID && k == Epi::MIDK) {
#pragma unroll
            for (int reg = 0; reg < 16; ++reg) { const int row = row0 + (reg & 3) + 8 * (reg >> 2) + 4 * h; float v0 = c0[reg], v1 = c1[reg]; E.mid(row, t, wid * 32 + r, v0, v1); c0[reg] = v0; c1[reg] = v1; }
        }
        const bf16x8 a = *(const bf16x8*)(ap + k), x0 = *(const bf16x8*)(b0 + k), x1 = *(const bf16x8*)(b1 + k);
        c0 = __builtin_amdgcn_mfma_f32_32x32x16_bf16(a, x0, c0, 0, 0, 0);
        c1 = __builtin_amdgcn_mfma_f32_32x32x16_bf16(a, x1, c1, 0, 0, 0);
    }
#pragma unroll
    for (int reg = 0; reg < 16; ++reg) {
        const int row = row0 + (reg & 3) + 8 * (reg >> 2) + 4 * h;
        const float rs = E.rowscale(row);
        E.elem(row, t, wid * 32 + r, c0[reg], c1[reg], rs);
    }
}

__device__ __forceinline__ void ld_row64(const bf16_t* p, float (&k)[64]) {
#pragma unroll
    for (int i = 0; i < 8; ++i) { const u32x4 w = *(const u32x4*)(p + 8 * i);
        k[8 * i + 0] = __uint_as_float(w.x << 16); k[8 * i + 1] = __uint_as_float(w.x & 0xffff0000u);
        k[8 * i + 2] = __uint_as_float(w.y << 16); k[8 * i + 3] = __uint_as_float(w.y & 0xffff0000u);
        k[8 * i + 4] = __uint_as_float(w.z << 16); k[8 * i + 5] = __uint_as_float(w.z & 0xffff0000u);
        k[8 * i + 6] = __uint_as_float(w.w << 16); k[8 * i + 7] = __uint_as_float(w.w & 0xffff0000u); }
}
__device__ __forceinline__ int block_sum_i(int v, int* red) {
    int s = v;
#pragma unroll
    for (int o = 1; o < 64; o <<= 1) s += __shfl_xor(s, o);
    __syncthreads();
    if ((threadIdx.x & 63) == 0) red[threadIdx.x >> 6] = s;
    __syncthreads();
    return (red[0] + red[1]) + (red[2] + red[3]);
}
__device__ __forceinline__ float block_sum_f(float v, float* red) {
    const float s = wave_sum(v);
    __syncthreads();
    if ((threadIdx.x & 63) == 0) red[threadIdx.x >> 6] = s;
    __syncthreads();
    return (red[0] + red[1]) + (red[2] + red[3]);
}

__global__ void __launch_bounds__(256) k_index_select(const bf16_t* IQ, const bf16_t* IK, const float* IW, unsigned* MASK) {
    __shared__ float q[512]; __shared__ float w[8]; __shared__ unsigned key[2048]; __shared__ unsigned msk[64]; __shared__ int red[4];
    const int tok = blockIdx.x, b = tok >> 11, s = tok & 2047, L = ((s >> 6) + 1) << 6, tid = threadIdx.x;
    for (int i = tid; i < 512; i += 256) q[i] = bf2f(IQ[(size_t)tok * 512 + i]);
    if (tid < 8) w[tid] = IW[(size_t)tok * 8 + tid];
    if (tid < 64) msk[tid] = 0u;
    __syncthreads();
    for (int j = tid; j < L; j += 256) {
        float k[64]; ld_row64(IK + (size_t)(b * SEQ + j) * 64, k);
        float sc = 0.f;
#pragma unroll
        for (int hh = 0; hh < 8; ++hh) { float d = 0.f;
#pragma unroll
            for (int i = 0; i < 64; ++i) d += q[hh * 64 + i] * k[i];
            sc += w[hh] * fmaxf(d, 0.f); }
        sc += 0.f;
        unsigned u = __float_as_uint(sc); u ^= (u >> 31) ? 0xffffffffu : 0x80000000u;
        key[j] = u;
    }
    __syncthreads();
    if (L <= 256) { for (int j = tid; j < L; j += 256) atomicOr(&msk[j >> 5], 1u << (j & 31)); }
    else {
        unsigned T = 0u;
        for (int bit = 31; bit >= 0; --bit) {
            const unsigned cand = T | (1u << bit); int c = 0;
            for (int j = tid; j < L; j += 256) c += key[j] >= cand ? 1 : 0;
            if (block_sum_i(c, red) >= 256) T = cand;
        }
        int c = 0;
        for (int j = tid; j < L; j += 256) { if (key[j] > T) { c++; atomicOr(&msk[j >> 5], 1u << (j & 31)); } }
        int need = 256 - block_sum_i(c, red);
        if (tid == 0) { for (int j = 0; j < L && need > 0; ++j) if (key[j] == T) { msk[j >> 5] |= 1u << (j & 31); --need; } }
    }
    __syncthreads();
    if (tid < 64) MASK[(size_t)tok * 64 + tid] = msk[tid];
}

__global__ void __launch_bounds__(256) k_attn_naive(bf16_t* YB, const bf16_t* AK, const bf16_t* AV, const unsigned* MASK) {
    __shared__ float q[512]; __shared__ unsigned msk[64]; __shared__ float lg[4][2048]; __shared__ float rinv[4];
    const int tok = blockIdx.x, b = tok >> 11, s = tok & 2047, L = ((s >> 6) + 1) << 6, tid = threadIdx.x, wid = tid >> 6, lane = tid & 63;
    for (int i = tid; i < 512; i += 256) q[i] = bf2f(YB[(size_t)tok * 1536 + i]);
    if (tid < 64) msk[tid] = MASK[(size_t)tok * 64 + tid];
    __syncthreads();
    for (int hg = 0; hg < 2; ++hg) {
        for (int j = tid; j < L; j += 256) {
            if ((msk[j >> 5] >> (j & 31)) & 1u) {
                float k[64]; ld_row64(AK + (size_t)(b * SEQ + j) * 64, k);
#pragma unroll
                for (int hh = 0; hh < 4; ++hh) { float d = 0.f;
#pragma unroll
                    for (int i = 0; i < 64; ++i) d += q[(hg * 4 + hh) * 64 + i] * k[i];
                    lg[hh][j] = d; }
            } else {
#pragma unroll
                for (int hh = 0; hh < 4; ++hh) lg[hh][j] = -1e30f;
            }
        }
        __syncthreads();
        {
            float m = -1e30f;
            for (int j = lane; j < L; j += 64) m = fmaxf(m, lg[wid][j]);
            m = wave_max(m);
            float sum = 0.f;
            for (int j = lane; j < L; j += 64) { const float x = lg[wid][j]; const float p = x > -5e29f ? __expf(x - m) : 0.f; lg[wid][j] = p; sum += p; }
            sum = wave_sum(sum);
            if (lane == 0) rinv[wid] = 1.f / sum;
        }
        __syncthreads();
        {
            float o = 0.f;
            for (int j = 0; j < L; ++j) { const float p = lg[wid][j]; if (p != 0.f) o += p * bf2f(AV[(size_t)(b * SEQ + j) * 64 + lane]); }
            YB[(size_t)tok * 1536 + (hg * 4 + wid) * 64 + lane] = f2bf(o * rinv[wid]);
        }
        __syncthreads();
    }
}

__global__ void __launch_bounds__(256) k_ret_naive(const bf16_t* RQ, const bf16_t* RK, const bf16_t* RV, bf16_t* YB) {
    __shared__ float q[128]; __shared__ float sc[256]; __shared__ float red[4];
    const int tok = blockIdx.x, h = blockIdx.y, b = tok >> 11, s = tok & 2047, L = ((s >> 6) + 1) << 6, tid = threadIdx.x;
    if (tid < 128) q[tid] = bf2f(RQ[(size_t)tok * 512 + h * 128 + tid]);
    __syncthreads();
    const float lg2 = log2f(1.f - exp2f(-5.f - (float)h));
    float y = 0.f;
    for (int j0 = 0; j0 < L; j0 += 256) {
        const int j = j0 + tid; float sv = 0.f;
        if (j < L) {
            const bf16_t* kr = RK + (size_t)(b * SEQ + j) * 512 + h * 128; float d = 0.f;
#pragma unroll
            for (int hf = 0; hf < 2; ++hf) { float k[64]; ld_row64(kr + 64 * hf, k);
#pragma unroll
                for (int i = 0; i < 64; ++i) d += q[hf * 64 + i] * k[i]; }
            const int dist = s > j ? s - j : j - s;
            sv = d * exp2f(lg2 * (float)dist);
        }
        sc[tid] = sv;
        __syncthreads();
        const int n = (L - j0) < 256 ? (L - j0) : 256;
        for (int jj = 0; jj < n; ++jj) y += sc[jj] * bf2f(RV[(size_t)(b * SEQ + j0 + jj) * 1024 + h * 256 + tid]);
        __syncthreads();
    }
    const float mean = block_sum_f(y, red) * (1.f / 256.f);
    const float dv = y - mean;
    const float var = block_sum_f(dv * dv, red) * (1.f / 256.f);
    const float yn = dv * rsqrtf(var + GN_EPS);
    bf16_t* o = YB + (size_t)tok * 1536 + 512 + h * 256 + tid;
    *o = f2bf(yn * bf2f(*o));
}

__global__ void __launch_bounds__(256) k_final(float* h, const float* ss, const float* g) {
    const int row = blockIdx.x, tid = threadIdx.x;
    const float rs = row_rstd(ss, row);
    f32x4 v = *(const f32x4*)(h + (size_t)row * D + tid * 4); const f32x4 gg = *(const f32x4*)(g + tid * 4);
    v.x *= rs * gg.x; v.y *= rs * gg.y; v.z *= rs * gg.z; v.w *= rs * gg.w;
    *(f32x4*)(h + (size_t)row * D + tid * 4) = v;
}

extern "C" void kernel_launch(void* const* d_in, const int* in_sizes, int n_in, void* d_out, int out_size, void* d_ws, size_t ws_size, hipStream_t stream) {
    if (n_in != 21 || out_size != M * D || ws_size < WS_END) { fprintf(stderr, "kernel_launch: unexpected shapes (n_in %d out %d ws %zu)\n", n_in, out_size, ws_size); return; }
    const float* x = (const float*)d_in[0]; const float* p = (const float*)d_in[1]; const int* pos = (const int*)d_in[2];
    const float* g1 = (const float*)d_in[3]; const float* wg1 = (const float*)d_in[4]; const float* wu1 = (const float*)d_in[5]; const float* wd1 = (const float*)d_in[6];
    const float* gmix = (const float*)d_in[7]; const float* win = (const float*)d_in[8]; const float* retgn = (const float*)d_in[9];
    const float* wba = (const float*)d_in[10]; const float* wbb = (const float*)d_in[11]; const float* wout = (const float*)d_in[12];
    const float* g2 = (const float*)d_in[13]; const float* wg2 = (const float*)d_in[14]; const float* wu2 = (const float*)d_in[15]; const float* wd2 = (const float*)d_in[16];
    const float* gple = (const float*)d_in[17]; const float* wpg = (const float*)d_in[18]; const float* wpp = (const float*)d_in[19]; const float* gfin = (const float*)d_in[20];
    unsigned char* ws = (unsigned char*)d_ws; float* H = (float*)d_out;
#define WSP(T, off) ((T*)(ws + (off)))
    bf16_t *WGU1 = WSP(bf16_t, WS_WGU1), *WD1 = WSP(bf16_t, WS_WD1), *WIN = WSP(bf16_t, WS_WIN), *WGATE = WSP(bf16_t, WS_WGATE), *WAB = WSP(bf16_t, WS_WAB), *WOUT = WSP(bf16_t, WS_WOUT);
    bf16_t *WGU2 = WSP(bf16_t, WS_WGU2), *WD2 = WSP(bf16_t, WS_WD2), *WPG = WSP(bf16_t, WS_WPG), *WPP = WSP(bf16_t, WS_WPP);
    float *CS64 = WSP(float, WS_CS64), *CS32 = WSP(float, WS_CS32), *SS0 = WSP(float, WS_SS0), *SS1 = WSP(float, WS_SS1);
    bf16_t *HB = WSP(bf16_t, WS_HB), *PB = WSP(bf16_t, WS_PB), *HID = WSP(bf16_t, WS_HID), *IQ = WSP(bf16_t, WS_IQ), *RQ = WSP(bf16_t, WS_RQ), *RK = WSP(bf16_t, WS_RK);
    bf16_t *AK = WSP(bf16_t, WS_AK), *AV = WSP(bf16_t, WS_AV), *IK = WSP(bf16_t, WS_IK), *GA = WSP(bf16_t, WS_GA), *GB = WSP(bf16_t, WS_GB), *MERGED = WSP(bf16_t, WS_MERGED);
    bf16_t *YB = WSP(bf16_t, WS_YB), *RV = WSP(bf16_t, WS_RV);
    float *IW = WSP(float, WS_IW), *PP = WSP(float, WS_PP); unsigned* MASK = WSP(unsigned, WS_MASK);
    const dim3 tb(32, 8);
    hipLaunchKernelGGL(prep_wt<SrcGU>, dim3(5632 / 32, 1024 / 32), tb, 0, stream, SrcGU{wg1, wu1, g1}, WGU1, 1024);
    hipLaunchKernelGGL(prep_wt<SrcPlain>, dim3(1024 / 32, 2816 / 32), tb, 0, stream, SrcPlain{wd1, 1024, nullptr, 1.f}, WD1, 2816);
    hipLaunchKernelGGL(prep_wt<SrcWin>, dim3(4352 / 32, 1024 / 32), tb, 0, stream, SrcWin{win, gmix}, WIN, 1024);
    hipLaunchKernelGGL(prep_wt<SrcPlain>, dim3(2048 / 32, 1024 / 32), tb, 0, stream, SrcPlain{win + 4296, INW, gmix, 1.f}, WGATE, 1024);
    hipLaunchKernelGGL(prep_wt<SrcPlain>, dim3(1024 / 32, 512 / 32), tb, 0, stream, SrcPlain{wba, 1024, nullptr, 1.f}, WAB, 1536);
    hipLaunchKernelGGL(prep_wt<SrcPlain>, dim3(1024 / 32, 1024 / 32), tb, 0, stream, SrcPlain{wbb, 1024, retgn, 1.f}, WAB + 512, 1536);
    hipLaunchKernelGGL(prep_wt<SrcPlain>, dim3(1024 / 32, 1024 / 32), tb, 0, stream, SrcPlain{wout, 1024, nullptr, 1.f}, WOUT, 1024);
    hipLaunchKernelGGL(prep_wt<SrcGU>, dim3(5632 / 32, 1024 / 32), tb, 0, stream, SrcGU{wg2, wu2, g2}, WGU2, 1024);
    hipLaunchKernelGGL(prep_wt<SrcPlain>, dim3(1024 / 32, 2816 / 32), tb, 0, stream, SrcPlain{wd2, 1024, nullptr, 1.f}, WD2, 2816);
    hipLaunchKernelGGL(prep_wt<SrcPlain>, dim3(1024 / 32, 1024 / 32), tb, 0, stream, SrcPlain{wpg, 1024, gple, 1.f}, WPG, 1024);
    hipLaunchKernelGGL(prep_wt<SrcPlain>, dim3(1024 / 32, 256 / 32), tb, 0, stream, SrcPlain{wpp, 1024, nullptr, 1.f}, WPP, 256);
    hipLaunchKernelGGL(prep_x, dim3(M), dim3(256), 0, stream, x, HB, SS0);
    hipLaunchKernelGGL(prep_p, dim3(M * 256 / 1024), dim3(256), 0, stream, p, PB);
    hipLaunchKernelGGL(prep_rope, dim3(M * 64 / 256), dim3(256), 0, stream, pos, CS64, CS32);
    hipLaunchKernelGGL(ngemm<EGU>, dim3(M / 32, 22), dim3(256), 0, stream, HB, 1024, WGU1, 1024, 1024, EGU{SS0, HID});
    hipLaunchKernelGGL(ngemm<ERES>, dim3(M / 32, 4), dim3(256), 0, stream, HID, 2816, WD1, 2816, 2816, ERES{x, H, HB, 0.5f});
    hipLaunchKernelGGL(k_rowss, dim3(M), dim3(256), 0, stream, H, SS1);
    hipLaunchKernelGGL(ngemm<EWIN>, dim3(M / 32, 17), dim3(256), 0, stream, HB, 1024, WIN, 1024, 1024, EWIN{SS1, CS64, CS32, YB, AK, AV, IQ, IK, RQ, RK, RV, IW});
    hipLaunchKernelGGL(k_index_select, dim3(M), dim3(256), 0, stream, IQ, IK, IW, MASK);
    hipLaunchKernelGGL(k_attn_naive, dim3(M), dim3(256), 0, stream, YB, AK, AV, MASK);
    hipLaunchKernelGGL(k_ret_naive, dim3(M, 4), dim3(256), 0, stream, RQ, RK, RV, YB);
    hipLaunchKernelGGL(ngemm<EGATE>, dim3(M / 32, 8), dim3(256), 0, stream, HB, 1024, WGATE, 1024, 1024, EGATE{SS1, GA, GB});
    hipLaunchKernelGGL(ngemm<EBR>, dim3(M / 32, 4), dim3(256), 0, stream, YB, 1536, WAB, 1536, 1536, EBR{GA, GB, MERGED});
    hipLaunchKernelGGL(ngemm<ERES>, dim3(M / 32, 4), dim3(256), 0, stream, MERGED, 1024, WOUT, 1024, 1024, ERES{H, H, HB, 1.f});
    hipLaunchKernelGGL(k_rowss, dim3(M), dim3(256), 0, stream, H, SS0);
    hipLaunchKernelGGL(ngemm<EGU>, dim3(M / 32, 22), dim3(256), 0, stream, HB, 1024, WGU2, 1024, 1024, EGU{SS0, HID});
    hipLaunchKernelGGL(ngemm<ERES>, dim3(M / 32, 4), dim3(256), 0, stream, HID, 2816, WD2, 2816, 2816, ERES{H, H, HB, 0.5f});
    hipLaunchKernelGGL(k_rowss, dim3(M), dim3(256), 0, stream, H, SS1);
    hipLaunchKernelGGL(ngemm<EPP>, dim3(M / 32, 4), dim3(256), 0, stream, PB, 256, WPP, 256, 256, EPP{PP});
    hipLaunchKernelGGL(ngemm<EPLE>, dim3(M / 32, 4), dim3(256), 0, stream, HB, 1024, WPG, 1024, 1024, EPLE{SS1, PP, H});
    hipLaunchKernelGGL(k_rowss, dim3(M), dim3(256), 0, stream, H, SS0);
    hipLaunchKernelGGL(k_final, dim3(M), dim3(256), 0, stream, H, SS0, gfin);
#undef WSP
}
```

```cpp
#include <hip/hip_runtime.h>
#include <cstdint>
#include <cstdio>

typedef unsigned short bf16_t;
typedef short bf16x8 __attribute__((ext_vector_type(8)));
typedef float f32x4 __attribute__((ext_vector_type(4)));
typedef float f32x16 __attribute__((ext_vector_type(16)));
typedef unsigned u32x4 __attribute__((ext_vector_type(4)));
typedef unsigned u32x2 __attribute__((ext_vector_type(2)));

#ifndef PROBE_REP
#define PROBE_REP -1
#endif
constexpr int M = 32768, D = 1024, FF = 2816, SEQ = 2048, NBATCH = 16, INW = 6344;
constexpr float EPS = 1e-6f, GN_EPS = 1e-5f;

constexpr size_t MiB = 1u << 20;
constexpr size_t WS_CTL = 0;
constexpr size_t WS_WGU1 = 1 * MiB;
constexpr size_t WS_WD1 = WS_WGU1 + 11 * MiB;
constexpr size_t WS_WIN = WS_WD1 + 11 * MiB / 2;
constexpr size_t WS_WGATE = WS_WIN + 17 * MiB / 2;
constexpr size_t WS_WAB = WS_WGATE + 4 * MiB;
constexpr size_t WS_WOUT = WS_WAB + 3 * MiB;
constexpr size_t WS_WGU2 = WS_WOUT + 2 * MiB;
constexpr size_t WS_WD2 = WS_WGU2 + 11 * MiB;
constexpr size_t WS_WPG = WS_WD2 + 11 * MiB / 2;
constexpr size_t WS_WPP = WS_WPG + 2 * MiB;
constexpr size_t WS_CS64 = 56 * MiB;
constexpr size_t WS_CS32 = 72 * MiB;
constexpr size_t WS_SS0 = 80 * MiB;
constexpr size_t WS_SS1 = 82 * MiB;
constexpr size_t WS_HB = 84 * MiB;
constexpr size_t WS_PB = 148 * MiB;
constexpr size_t WS_R1 = 164 * MiB;
constexpr size_t WS_HID = WS_R1;
constexpr size_t WS_IQ = WS_R1;
constexpr size_t WS_RQ = WS_R1 + 32 * MiB;
constexpr size_t WS_RK = WS_R1 + 64 * MiB;
constexpr size_t WS_AK = WS_R1 + 96 * MiB;
constexpr size_t WS_AV = WS_R1 + 100 * MiB;
constexpr size_t WS_IK = WS_R1 + 104 * MiB;
constexpr size_t WS_IW = WS_R1 + 108 * MiB;
constexpr size_t WS_MASK = WS_R1 + 109 * MiB;
constexpr size_t WS_AVT = WS_R1 + 117 * MiB;
constexpr size_t WS_GA = WS_R1;
constexpr size_t WS_MERGED = WS_R1 + 64 * MiB;
constexpr size_t WS_PP = WS_R1;
constexpr size_t WS_R2 = 340 * MiB;
constexpr size_t WS_YB = WS_R2;
constexpr size_t WS_RV = WS_R2 + 96 * MiB;
constexpr size_t WS_GB = WS_RV;
constexpr size_t WS_END = 500 * MiB;
static_assert(WS_WPP + MiB / 2 <= WS_CS64 && WS_MASK + 8 * MiB <= WS_R1 + 176 * MiB && WS_R1 + 176 * MiB == WS_R2 && WS_RV + 64 * MiB == WS_END, "ws map");

__device__ __forceinline__ float bf2f(bf16_t b) { return __uint_as_float(((unsigned)b) << 16); }
__device__ __forceinline__ bf16_t f2bf(float f) { unsigned u = __float_as_uint(f); return (bf16_t)((u + 0x7fffu + ((u >> 16) & 1u)) >> 16); }
__device__ __forceinline__ float silu_f(float x) { return x / (1.f + __expf(-x)); }
__device__ __forceinline__ float sigm_f(float x) { return 1.f / (1.f + __expf(-x)); }
__device__ __forceinline__ float wave_sum(float v) {
#pragma unroll
    for (int o = 1; o < 64; o <<= 1) v += __shfl_xor(v, o);
    return v;
}
__device__ __forceinline__ float wave_max(float v) {
#pragma unroll
    for (int o = 1; o < 64; o <<= 1) v = fmaxf(v, __shfl_xor(v, o));
    return v;
}

__host__ __device__ __forceinline__ int win_src(int t, int c, float& sc) {
    sc = 1.f;
    const int hi = c >> 7, cc = c & 127;
    if (t < 2) { sc = 0.125f * 1.4426950408889634f; const int head = 4 * t + (cc >> 5), d = cc & 31; return head * 64 + hi * 32 + d; }
    if (t == 2) {
        if (!hi) { if (cc < 32) return 512 + cc; if (cc < 64) return 1152 + (cc - 32); if (cc < 96) return 576 + (cc - 64); return 576 + 32 + (cc - 96); }
        if (cc < 32) return 512 + 32 + cc; if (cc < 64) return 1152 + 32 + (cc - 32); if (cc < 72) { sc = 0.35355339059327373f; return 1216 + (cc - 64); } return -1;
    }
    if (t < 5) { sc = 0.125f; const int head = 4 * (t - 3) + (cc >> 5), d = cc & 31; return 640 + head * 64 + hi * 32 + d; }
    if (t < 7) { const int head = 2 * (t - 5) + (cc >> 6), d = cc & 63; return 1224 + head * 128 + hi * 64 + d; }
    if (t < 9) { sc = 0.08838834764831845f; const int head = 2 * (t - 7) + (cc >> 6), d = cc & 63; return 1736 + head * 128 + hi * 64 + d; }
    if (t < 13) return 2248 + 256 * (t - 9) + c;
    return 3272 + 256 * (t - 13) + c;
}

struct SrcPlain { const float* W; const float* gk; int ldw; float scale;
    __device__ float operator()(int n, int k) const { float v = W[(size_t)k * ldw + n]; if (gk) v *= gk[k]; return v * scale; }
    __device__ f32x4 f4(int n, int k) const { const f32x4 v = *(const f32x4*)(W + (size_t)k * ldw + n); return v * ((gk ? gk[k] : 1.f) * scale); } };
struct SrcGU { const float* Wg; const float* Wu; const float* gk;
    __device__ float operator()(int n, int k) const { const int t = n >> 8, c = n & 255; const long delta = (const char*)Wu - (const char*)Wg; const float* W = (const float*)((const char*)Wg + (c < 128 ? 0l : delta)); return W[(size_t)k * FF + t * 128 + (c & 127)] * gk[k]; }
    __device__ f32x4 f4(int n, int k) const { const int t = n >> 8, c = n & 255; const long delta = (const char*)Wu - (const char*)Wg; const float* W = (const float*)((const char*)Wg + (c < 128 ? 0l : delta)); return *(const f32x4*)(W + (size_t)k * FF + t * 128 + (c & 127)) * gk[k]; } };
struct SrcWin { const float* W; const float* gk;
    __device__ float operator()(int n, int k) const { float sc; const int col = win_src(n >> 8, n & 255, sc); if (col < 0) return 0.f; return W[(size_t)k * INW + col] * gk[k] * sc; }
    __device__ f32x4 f4(int n, int k) const { float sc; const int col = win_src(n >> 8, n & 255, sc); if (col < 0) return (f32x4){0.f, 0.f, 0.f, 0.f}; return *(const f32x4*)(W + (size_t)k * INW + col) * (gk[k] * sc); } };

template <class F> __global__ void __launch_bounds__(256) prep_wt(F f, bf16_t* out, int ldo) {
    __shared__ float tile[32][33];
    const int n0 = blockIdx.x * 32, k0 = blockIdx.y * 32, tx = threadIdx.x, ty = threadIdx.y;
    for (int i = ty; i < 32; i += 8) tile[i][tx] = f(n0 + tx, k0 + i);
    __syncthreads();
    for (int i = ty; i < 32; i += 8) out[(size_t)(n0 + i) * ldo + k0 + tx] = f2bf(tile[tx][i]);
}

__global__ void __launch_bounds__(256) prep_x(const float* x, bf16_t* hb, float* ss) {
    __shared__ float red[4];
    const int row = blockIdx.x, tid = threadIdx.x;
    const f32x4 v = *(const f32x4*)(x + (size_t)row * D + tid * 4);
    uint2 o; o.x = (unsigned)f2bf(v.x) | ((unsigned)f2bf(v.y) << 16); o.y = (unsigned)f2bf(v.z) | ((unsigned)f2bf(v.w) << 16);
    *(uint2*)(hb + (size_t)row * D + tid * 4) = o;
    float s = wave_sum(v.x * v.x + v.y * v.y + v.z * v.z + v.w * v.w);
    if ((tid & 63) == 0) red[tid >> 6] = s;
    __syncthreads();
    if (tid < 16) ss[(size_t)row * 16 + tid] = tid == 0 ? (red[0] + red[1]) + (red[2] + red[3]) : 0.f;
}
__global__ void __launch_bounds__(256) k_rowss(const float* h, float* ss) {
    __shared__ float red[4];
    const int row = blockIdx.x, tid = threadIdx.x;
    const f32x4 v = *(const f32x4*)(h + (size_t)row * D + tid * 4);
    float s = wave_sum(v.x * v.x + v.y * v.y + v.z * v.z + v.w * v.w);
    if ((tid & 63) == 0) red[tid >> 6] = s;
    __syncthreads();
    if (tid < 16) ss[(size_t)row * 16 + tid] = tid == 0 ? (red[0] + red[1]) + (red[2] + red[3]) : 0.f;
}
__global__ void __launch_bounds__(256) prep_p(const float* p, bf16_t* pb) {
    const size_t i = ((size_t)blockIdx.x * 256 + threadIdx.x) * 4;
    const f32x4 v = *(const f32x4*)(p + i);
    uint2 o; o.x = (unsigned)f2bf(v.x) | ((unsigned)f2bf(v.y) << 16); o.y = (unsigned)f2bf(v.z) | ((unsigned)f2bf(v.w) << 16);
    *(uint2*)(pb + i) = o;
}
__global__ void __launch_bounds__(256) prep_rope(const int* pos, float* cs64, float* cs32) {
    const int i = blockIdx.x * 256 + threadIdx.x, tok = i >> 6, k = i & 63;
    const float inv = powf(10000.f, -(float)k / 64.f);
    const float ang = (float)pos[tok] * inv;
    const float c = cosf(ang), s = sinf(ang);
    cs64[(size_t)tok * 128 + k] = c; cs64[(size_t)tok * 128 + 64 + k] = s;
    if ((k & 1) == 0) { cs32[(size_t)tok * 64 + (k >> 1)] = c; cs32[(size_t)tok * 64 + 32 + (k >> 1)] = s; }
}

__device__ __forceinline__ float row_rstd(const float* ss, int row) {
    const f32x4* p = (const f32x4*)(ss + (size_t)row * 16);
    const f32x4 a = p[0], b = p[1], c = p[2], d = p[3];
    const float s = ((a.x + a.y) + (a.z + a.w)) + ((b.x + b.y) + (b.z + b.w)) + ((c.x + c.y) + (c.z + c.w)) + ((d.x + d.y) + (d.z + d.w));
    return rsqrtf(s * (1.f / 1024.f) + EPS);
}
struct EGU {
    static constexpr bool HAS_MID = false; static constexpr int MIDK = 0;
    const float* ss; bf16_t* hid;
    __device__ float rowscale(int row) const { return row_rstd(ss, row); }
    __device__ void elem(int row, int t, int c, float v0, float v1, float rs) const { hid[(size_t)row * FF + t * 128 + c] = f2bf(silu_f(v0 * rs) * (v1 * rs)); }
    __device__ void mid(int, int, int, float&, float&) const {}
};
struct ERES {
    static constexpr bool HAS_MID = false; static constexpr int MIDK = 0;
    const float* res; float* H; bf16_t* hb; float sc;
    __device__ float rowscale(int) const { return 1.f; }
    __device__ void elem(int row, int t, int c, float v0, float v1, float) const {
        const size_t i0 = (size_t)row * D + t * 256 + c, i1 = i0 + 128;
        const float h0 = res[i0] + sc * v0, h1 = res[i1] + sc * v1;
        H[i0] = h0; H[i1] = h1; hb[i0] = f2bf(h0); hb[i1] = f2bf(h1);
    }
    __device__ void mid(int, int, int, float&, float&) const {}
};
struct EWIN {
    static constexpr bool HAS_MID = false; static constexpr int MIDK = 0;
    const float* ss; const float* cs64; const float* cs32;
    bf16_t *yb, *ak, *av, *iq, *ik, *rq, *rk, *rv; float* iw;
    __device__ float rowscale(int row) const { return row_rstd(ss, row); }
    __device__ void elem(int row, int t, int c, float v0, float v1, float rs) const {
        const float a = v0 * rs, b = v1 * rs;
        if (t < 2 || t == 3 || t == 4) {
            const int tt = t < 2 ? t : t - 3, head = 4 * tt + (c >> 5), d = c & 31;
            const float cs = cs32[(size_t)row * 64 + d], sn = cs32[(size_t)row * 64 + 32 + d];
            const float o1 = a * cs - b * sn, o2 = b * cs + a * sn;
            if (t < 2) { bf16_t* o = yb + (size_t)row * 1536 + head * 64 + d; o[0] = f2bf(o1); o[32] = f2bf(o2); }
            else { bf16_t* o = iq + (size_t)row * 512 + head * 64 + d; o[0] = f2bf(o1); o[32] = f2bf(o2); }
        } else if (t == 2) {
            if (c < 64) {
                const int d = c & 31;
                const float cs = cs32[(size_t)row * 64 + d], sn = cs32[(size_t)row * 64 + 32 + d];
                const float o1 = a * cs - b * sn, o2 = b * cs + a * sn;
                bf16_t* o = (c < 32 ? ak : ik) + (size_t)row * 64 + d; o[0] = f2bf(o1); o[32] = f2bf(o2);
            } else {
                av[(size_t)row * 64 + (c - 64)] = f2bf(a);
                if (c < 72) iw[(size_t)row * 8 + (c - 64)] = b;
            }
        } else if (t < 9) {
            const int tt = t < 7 ? t - 5 : t - 7, head = 2 * tt + (c >> 6), d = c & 63;
            const float cs = cs64[(size_t)row * 128 + d], sn = cs64[(size_t)row * 128 + 64 + d];
            const float o1 = a * cs - b * sn, o2 = b * cs + a * sn;
            bf16_t* o = (t < 7 ? rq : rk) + (size_t)row * 512 + head * 128 + d; o[0] = f2bf(o1); o[64] = f2bf(o2);
        } else if (t < 13) {
            bf16_t* o = rv + (size_t)row * 1024 + 256 * (t - 9) + c; o[0] = f2bf(a); o[128] = f2bf(b);
        } else {
            bf16_t* o = yb + (size_t)row * 1536 + 512 + 256 * (t - 13) + c; o[0] = f2bf(silu_f(a)); o[128] = f2bf(silu_f(b));
        }
    }
    __device__ void mid(int, int, int, float&, float&) const {}
};
struct EGATE {
    static constexpr bool HAS_MID = false; static constexpr int MIDK = 0;
    const float* ss; bf16_t *ga, *gb;
    __device__ float rowscale(int row) const { return row_rstd(ss, row); }
    __device__ void elem(int row, int t, int c, float v0, float v1, float rs) const {
        bf16_t* o = (t < 4 ? ga : gb) + (size_t)row * D + 256 * (t & 3) + c; o[0] = f2bf(sigm_f(v0 * rs)); o[128] = f2bf(sigm_f(v1 * rs));
    }
    __device__ void mid(int, int, int, float&, float&) const {}
};
struct EBR {
    static constexpr bool HAS_MID = true; static constexpr int MIDK = 512;
    const bf16_t *ga, *gb; bf16_t* merged;
    __device__ float rowscale(int) const { return 1.f; }
    __device__ void mid(int row, int t, int c, float& v0, float& v1) const {
        const size_t i0 = (size_t)row * D + 256 * t + c, i1 = i0 + 128;
        v0 *= bf2f(ga[i0]) / bf2f(gb[i0]); v1 *= bf2f(ga[i1]) / bf2f(gb[i1]);
    }
    __device__ void elem(int row, int t, int c, float v0, float v1, float) const {
        const size_t i0 = (size_t)row * D + 256 * t + c, i1 = i0 + 128;
        merged[i0] = f2bf(v0 * bf2f(gb[i0])); merged[i1] = f2bf(v1 * bf2f(gb[i1]));
    }
};
struct EPP {
    static constexpr bool HAS_MID = false; static constexpr int MIDK = 0;
    float* pp;
    __device__ float rowscale(int) const { return 1.f; }
    __device__ void elem(int row, int t, int c, float v0, float v1, float) const { const size_t i0 = (size_t)row * D + 256 * t + c; pp[i0] = v0; pp[i0 + 128] = v1; }
    __device__ void mid(int, int, int, float&, float&) const {}
};
struct EPLE {
    static constexpr bool HAS_MID = false; static constexpr int MIDK = 0;
    const float* ss; const float* pp; float* H;
    __device__ float rowscale(int row) const { return row_rstd(ss, row); }
    __device__ void elem(int row, int t, int c, float v0, float v1, float rs) const {
        const size_t i0 = (size_t)row * D + 256 * t + c, i1 = i0 + 128;
        H[i0] = H[i0] + sigm_f(v0 * rs) * pp[i0]; H[i1] = H[i1] + sigm_f(v1 * rs) * pp[i1];
    }
    __device__ void mid(int, int, int, float&, float&) const {}
};

template <class Epi> __global__ void __launch_bounds__(256) ngemm(const bf16_t* A, int lda, const bf16_t* Bt, int ldb, int K, Epi E) {
    const int wid = threadIdx.x >> 6, lane = threadIdx.x & 63, r = lane & 31, h = lane >> 5;
    const int row0 = blockIdx.x * 32, t = blockIdx.y;
    const bf16_t* ap = A + (size_t)(row0 + r) * lda + 8 * h;
    const bf16_t* b0 = Bt + (size_t)(t * 256 + wid * 32 + r) * ldb + 8 * h;
    const bf16_t* b1 = b0 + (size_t)128 * ldb;
    f32x16 c0, c1;
#pragma unroll
    for (int i = 0; i < 16; ++i) { c0[i] = 0.f; c1[i] = 0.f; }
    for (int k = 0; k < K; k += 16) {
        if (Epi::HAS_MID && k == Epi::MIDK) {
#pragma unroll
            for (int reg = 0; reg < 16; ++reg) { const int row = row0 + (reg & 3) + 8 * (reg >> 2) + 4 * h; float v0 = c0[reg], v1 = c1[reg]; E.mid(row, t, wid * 32 + r, v0, v1); c0[reg] = v0; c1[reg] = v1; }
        }
        const bf16x8 a = *(const bf16x8*)(ap + k), x0 = *(const bf16x8*)(b0 + k), x1 = *(const bf16x8*)(b1 + k);
        c0 = __builtin_amdgcn_mfma_f32_32x32x16_bf16(a, x0, c0, 0, 0, 0);
        c1 = __builtin_amdgcn_mfma_f32_32x32x16_bf16(a, x1, c1, 0, 0, 0);
    }
#pragma unroll
    for (int reg = 0; reg < 16; ++reg) {
        const int row = row0 + (reg & 3) + 8 * (reg >> 2) + 4 * h;
        const float rs = E.rowscale(row);
        E.elem(row, t, wid * 32 + r, c0[reg], c1[reg], rs);
    }
}

__device__ __forceinline__ void ld_row64(const bf16_t* p, float (&k)[64]) {
#pragma unroll
    for (int i = 0; i < 8; ++i) { const u32x4 w = *(const u32x4*)(p + 8 * i);
        k[8 * i + 0] = __uint_as_float(w.x << 16); k[8 * i + 1] = __uint_as_float(w.x & 0xffff0000u);
        k[8 * i + 2] = __uint_as_float(w.y << 16); k[8 * i + 3] = __uint_as_float(w.y & 0xffff0000u);
        k[8 * i + 4] = __uint_as_float(w.z << 16); k[8 * i + 5] = __uint_as_float(w.z & 0xffff0000u);
        k[8 * i + 6] = __uint_as_float(w.w << 16); k[8 * i + 7] = __uint_as_float(w.w & 0xffff0000u); }
}
__device__ __forceinline__ int block_sum_i(int v, int* red) {
    int s = v;
#pragma unroll
    for (int o = 1; o < 64; o <<= 1) s += __shfl_xor(s, o);
    __syncthreads();
    if ((threadIdx.x & 63) == 0) red[threadIdx.x >> 6] = s;
    __syncthreads();
    return (red[0] + red[1]) + (red[2] + red[3]);
}
__device__ __forceinline__ float block_sum_f(float v, float* red) {
    const float s = wave_sum(v);
    __syncthreads();
    if ((threadIdx.x & 63) == 0) red[threadIdx.x >> 6] = s;
    __syncthreads();
    return (red[0] + red[1]) + (red[2] + red[3]);
}

__global__ void __launch_bounds__(256) k_index_select(const bf16_t* IQ, const bf16_t* IK, const float* IW, unsigned* MASK) {
    __shared__ float q[512]; __shared__ float w[8]; __shared__ unsigned key[2048]; __shared__ unsigned msk[64]; __shared__ int red[4];
    const int tok = blockIdx.x, b = tok >> 11, s = tok & 2047, L = ((s >> 6) + 1) << 6, tid = threadIdx.x;
    for (int i = tid; i < 512; i += 256) q[i] = bf2f(IQ[(size_t)tok * 512 + i]);
    if (tid < 8) w[tid] = IW[(size_t)tok * 8 + tid];
    if (tid < 64) msk[tid] = 0u;
    __syncthreads();
    for (int j = tid; j < L; j += 256) {
        float k[64]; ld_row64(IK + (size_t)(b * SEQ + j) * 64, k);
        float sc = 0.f;
#pragma unroll
        for (int hh = 0; hh < 8; ++hh) { float d = 0.f;
#pragma unroll
            for (int i = 0; i < 64; ++i) d += q[hh * 64 + i] * k[i];
            sc += w[hh] * fmaxf(d, 0.f); }
        sc += 0.f;
        unsigned u = __float_as_uint(sc); u ^= (u >> 31) ? 0xffffffffu : 0x80000000u;
        key[j] = u;
    }
    __syncthreads();
    if (L <= 256) { for (int j = tid; j < L; j += 256) atomicOr(&msk[j >> 5], 1u << (j & 31)); }
    else {
        unsigned T = 0u;
        for (int bit = 31; bit >= 0; --bit) {
            const unsigned cand = T | (1u << bit); int c = 0;
            for (int j = tid; j < L; j += 256) c += key[j] >= cand ? 1 : 0;
            if (block_sum_i(c, red) >= 256) T = cand;
        }
        int c = 0;
        for (int j = tid; j < L; j += 256) { if (key[j] > T) { c++; atomicOr(&msk[j >> 5], 1u << (j & 31)); } }
        int need = 256 - block_sum_i(c, red);
        if (tid == 0) { for (int j = 0; j < L && need > 0; ++j) if (key[j] == T) { msk[j >> 5] |= 1u << (j & 31); --need; } }
    }
    __syncthreads();
    if (tid < 64) MASK[(size_t)tok * 64 + tid] = msk[tid];
}

__global__ void __launch_bounds__(256) k_attn_naive(bf16_t* YB, const bf16_t* AK, const bf16_t* AV, const unsigned* MASK) {
    __shared__ float q[512]; __shared__ unsigned msk[64]; __shared__ float lg[4][2048]; __shared__ float rinv[4];
    const int tok = blockIdx.x, b = tok >> 11, s = tok & 2047, L = ((s >> 6) + 1) << 6, tid = threadIdx.x, wid = tid >> 6, lane = tid & 63;
    for (int i = tid; i < 512; i += 256) q[i] = bf2f(YB[(size_t)tok * 1536 + i]);
    if (tid < 64) msk[tid] = MASK[(size_t)tok * 64 + tid];
    __syncthreads();
    for (int hg = 0; hg < 2; ++hg) {
        for (int j = tid; j < L; j += 256) {
            if ((msk[j >> 5] >> (j & 31)) & 1u) {
                float k[64]; ld_row64(AK + (size_t)(b * SEQ + j) * 64, k);
#pragma unroll
                for (int hh = 0; hh < 4; ++hh) { float d = 0.f;
#pragma unroll
                    for (int i = 0; i < 64; ++i) d += q[(hg * 4 + hh) * 64 + i] * k[i];
                    lg[hh][j] = d; }
            } else {
#pragma unroll
                for (int hh = 0; hh < 4; ++hh) lg[hh][j] = -1e30f;
            }
        }
        __syncthreads();
        {
            float m = -1e30f;
            for (int j = lane; j < L; j += 64) m = fmaxf(m, lg[wid][j]);
            m = wave_max(m);
            float sum = 0.f;
            for (int j = lane; j < L; j += 64) { const float x = lg[wid][j]; const float p = x > -5e29f ? __expf(x - m) : 0.f; lg[wid][j] = p; sum += p; }
            sum = wave_sum(sum);
            if (lane == 0) rinv[wid] = 1.f / sum;
        }
        __syncthreads();
        {
            float o = 0.f;
            for (int j = 0; j < L; ++j) { const float p = lg[wid][j]; if (p != 0.f) o += p * bf2f(AV[(size_t)(b * SEQ + j) * 64 + lane]); }
            YB[(size_t)tok * 1536 + (hg * 4 + wid) * 64 + lane] = f2bf(o * rinv[wid]);
        }
        __syncthreads();
    }
}

__global__ void __launch_bounds__(256) k_ret_naive(const bf16_t* RQ, const bf16_t* RK, const bf16_t* RV, bf16_t* YB) {
    __shared__ float q[128]; __shared__ float sc[256]; __shared__ float red[4];
    const int tok = blockIdx.x, h = blockIdx.y, b = tok >> 11, s = tok & 2047, L = ((s >> 6) + 1) << 6, tid = threadIdx.x;
    if (tid < 128) q[tid] = bf2f(RQ[(size_t)tok * 512 + h * 128 + tid]);
    __syncthreads();
    const float lg2 = log2f(1.f - exp2f(-5.f - (float)h));
    float y = 0.f;
    for (int j0 = 0; j0 < L; j0 += 256) {
        const int j = j0 + tid; float sv = 0.f;
        if (j < L) {
            const bf16_t* kr = RK + (size_t)(b * SEQ + j) * 512 + h * 128; float d = 0.f;
#pragma unroll
            for (int hf = 0; hf < 2; ++hf) { float k[64]; ld_row64(kr + 64 * hf, k);
#pragma unroll
                for (int i = 0; i < 64; ++i) d += q[hf * 64 + i] * k[i]; }
            const int dist = s > j ? s - j : j - s;
            sv = d * exp2f(lg2 * (float)dist);
        }
        sc[tid] = sv;
        __syncthreads();
        const int n = (L - j0) < 256 ? (L - j0) : 256;
        for (int jj = 0; jj < n; ++jj) y += sc[jj] * bf2f(RV[(size_t)(b * SEQ + j0 + jj) * 1024 + h * 256 + tid]);
        __syncthreads();
    }
    const float mean = block_sum_f(y, red) * (1.f / 256.f);
    const float dv = y - mean;
    const float var = block_sum_f(dv * dv, red) * (1.f / 256.f);
    const float yn = dv * rsqrtf(var + GN_EPS);
    bf16_t* o = YB + (size_t)tok * 1536 + 512 + h * 256 + tid;
    *o = f2bf(yn * bf2f(*o));
}

__global__ void __launch_bounds__(256) k_final(float* h, const float* ss, const float* g) {
    const int row = blockIdx.x, tid = threadIdx.x;
    const float rs = row_rstd(ss, row);
    f32x4 v = *(const f32x4*)(h + (size_t)row * D + tid * 4); const f32x4 gg = *(const f32x4*)(g + tid * 4);
    v.x *= rs * gg.x; v.y *= rs * gg.y; v.z *= rs * gg.z; v.w *= rs * gg.w;
    *(f32x4*)(h + (size_t)row * D + tid * 4) = v;
}


namespace pg8 {
#define PG8_LAS __attribute__((address_space(3)))
constexpr int BM = 256, BK = 64, HALF = 128, HTB = HALF * BK * 2, STAGE_BYTES = 8 * HTB, NXCD = 8, WGM = 4;
__host__ __device__ __forceinline__ int lds_byte(int r, int c) { const int st = (r >> 4) * 2 + (c >> 5), rr = r & 15, cc = c & 31, ob = rr * 64 + cc * 2; return st * 1024 + (ob ^ (((ob >> 9) & 1) << 5)); }
__host__ __device__ __forceinline__ void stage_rc(int b, int& R, int& C) { const int st = b / 1024, sb = b % 1024, swz = sb ^ (((sb >> 9) & 1) << 5); R = (st >> 1) * 16 + swz / 64; C = (st & 1) * 32 + (swz % 64) / 2; }
struct Unit { int pm, pn; };
struct Gemm { const bf16_t* A; const bf16_t* Bt; int M, N, K; };
struct StaticOrder {
    int nM, nN, nwg, G, c;
    __device__ __forceinline__ void init(int M_, int N_, int G_, int c_) { nM = M_ / BM; nN = N_ / BM; nwg = nM * nN; G = G_; c = c_; }
    __device__ __forceinline__ bool next(int i, Unit& u) const {
        const long L = (long)i * G + c; if (L >= nwg) return false;
        int wgid = (int)L; { const int q = nwg / NXCD, r = nwg % NXCD, xcd = wgid % NXCD, off = wgid / NXCD; wgid = (xcd < r ? xcd * (q + 1) : r * (q + 1) + (xcd - r) * q) + off; }
        const int nig = WGM * nN, gid = wgid / nig, fm = gid * WGM, gsz = (nM - fm) < WGM ? (nM - fm) : WGM;
        u.pm = fm + ((wgid % nig) % gsz); u.pn = (wgid % nig) / gsz; return true;
    }
};
__device__ __forceinline__ unsigned cvt_pk_bf16(float lo, float hi) { unsigned r; asm volatile("v_cvt_pk_bf16_f32 %0, %1, %2" : "=v"(r) : "v"(lo), "v"(hi)); return r; }
__device__ __forceinline__ uint2 pack4(f32x4 v) { uint2 o; o.x = cvt_pk_bf16(v[0], v[1]); o.y = cvt_pk_bf16(v[2], v[3]); return o; }
__device__ __forceinline__ f32x4 unpack4(uint2 w) { f32x4 v; v[0] = __uint_as_float(w.x << 16); v[1] = __uint_as_float(w.x & 0xffff0000u); v[2] = __uint_as_float(w.y << 16); v[3] = __uint_as_float(w.y & 0xffff0000u); return v; }
__device__ __forceinline__ float fsigm(float x) { return __builtin_amdgcn_rcpf(1.f + __builtin_amdgcn_exp2f(-1.4426950408889634f * x)); }
__device__ __forceinline__ f32x4 silu4(f32x4 x) { f32x4 r; for (int i = 0; i < 4; ++i) r[i] = x[i] * fsigm(x[i]); return r; }
__device__ __forceinline__ f32x4 sigm4(f32x4 x) { f32x4 r; for (int i = 0; i < 4; ++i) r[i] = fsigm(x[i]); return r; }

enum { EK_GU = 0, EK_RES = 1, EK_WIN = 2, EK_GATE = 3, EK_BR = 4, EK_PP = 5, EK_PLE = 6 };
struct UEpi {
    static constexpr bool PERM = false;
    int kind, mid_t; float sc;
    const float* ss; float* ssout; const float* res; float* H; bf16_t* hb; bf16_t* o;
    const float* cs64; const float* cs32; bf16_t *yb, *ak, *av, *avt, *iq, *ik, *rq, *rk, *rv; float* iw;
    const bf16_t *ga, *gb; float* pp;
    const PG8_LAS float* rs_tab;
    __device__ __forceinline__ void rope_store(bf16_t* p1, bf16_t* p2, f32x4 a, f32x4 b, const float* cs, const float* sn) const {
        const f32x4 c = *(const f32x4*)cs, s = *(const f32x4*)sn;
        *(uint2*)p1 = pack4(a * c - b * s); *(uint2*)p2 = pack4(b * c + a * s);
    }
    __device__ __forceinline__ void mid(f32x4 (&acc)[2][2][4][2], const Unit& u, int wr, int wc, int fr, int fq) const {
#pragma unroll
        for (int ai = 0; ai < 2; ++ai)
#pragma unroll
            for (int m = 0; m < 4; ++m) { const int row = u.pm * BM + ai * HALF + wr * 64 + m * 16 + fr;
#pragma unroll
                for (int bj = 0; bj < 2; ++bj)
#pragma unroll
                    for (int n = 0; n < 2; ++n) { const size_t idx = (size_t)row * D + u.pn * BM + bj * HALF + wc * 32 + n * 16 + fq * 4;
                        const f32x4 a = unpack4(*(const uint2*)(ga + idx)), b = unpack4(*(const uint2*)(gb + idx));
                        f32x4 r; for (int i = 0; i < 4; ++i) r[i] = a[i] * __builtin_amdgcn_rcpf(b[i]);
                        acc[ai][bj][m][n] = acc[ai][bj][m][n] * r; }
                asm volatile("" ::: "memory"); }
    }
    __device__ __forceinline__ void row_scales(float (&rs)[8], int ui, int wr, int fr) const {
#pragma unroll
        for (int j = 0; j < 8; ++j) rs[j] = rs_tab[ui * 256 + (j >> 2) * HALF + wr * 64 + (j & 3) * 16 + fr];
    }
#define EPI_ROWS(...) _Pragma("unroll") for (int ai = 0; ai < 2; ++ai) _Pragma("unroll") for (int m = 0; m < 4; ++m) { const int row = u.pm * BM + ai * HALF + wr * 64 + m * 16 + fr; \
        _Pragma("unroll") for (int n = 0; n < 2; ++n) { const int c0 = wc * 32 + n * 16 + fq * 4; __VA_ARGS__ } if (m & 1) asm volatile("" ::: "memory"); }
    __device__ __forceinline__ void epi_gu(const f32x4 (&acc)[2][2][4][2], const Unit& u, int wr, int wc, int fr, int fq, int ui) const {
        float rs[8]; row_scales(rs, ui, wr, fr); const int t = u.pn;
        EPI_ROWS({ const float r = rs[ai * 4 + m]; *(uint2*)(o + (size_t)row * FF + t * 128 + c0) = pack4(silu4(acc[ai][0][m][n] * r) * (acc[ai][1][m][n] * r)); })
    }
    __device__ __forceinline__ void epi_gate(const f32x4 (&acc)[2][2][4][2], const Unit& u, int wr, int wc, int fr, int fq, int ui) const {
        float rs[8]; row_scales(rs, ui, wr, fr); const int t = u.pn;
        EPI_ROWS({ const float r = rs[ai * 4 + m]; bf16_t* p = o + (size_t)row * D + t * BM + c0; *(uint2*)p = pack4(sigm4(acc[ai][0][m][n] * r)); *(uint2*)(p + HALF) = pack4(sigm4(acc[ai][1][m][n] * r)); })
    }
    __device__ __forceinline__ void epi_br(const f32x4 (&acc)[2][2][4][2], const Unit& u, int wr, int wc, int fr, int fq, int ui) const {
        const int t = u.pn;
        EPI_ROWS({ const size_t i0 = (size_t)row * D + t * BM + c0, i1 = i0 + HALF;
            *(uint2*)(o + i0) = pack4(acc[ai][0][m][n] * unpack4(*(const uint2*)(gb + i0))); *(uint2*)(o + i1) = pack4(acc[ai][1][m][n] * unpack4(*(const uint2*)(gb + i1))); })
    }
    __device__ __forceinline__ void epi_pp(const f32x4 (&acc)[2][2][4][2], const Unit& u, int wr, int wc, int fr, int fq, int ui) const {
        const int t = u.pn;
        EPI_ROWS({ const size_t i0 = (size_t)row * D + t * BM + c0; *(f32x4*)(pp + i0) = acc[ai][0][m][n]; *(f32x4*)(pp + i0 + HALF) = acc[ai][1][m][n]; })
    }
    __device__ __forceinline__ void epi_res(const f32x4 (&acc)[2][2][4][2], const Unit& u, int wr, int wc, int fr, int fq, int ui) const {
        const int t = u.pn;
#pragma unroll
        for (int ai = 0; ai < 2; ++ai)
#pragma unroll
            for (int m = 0; m < 4; ++m) { const int row = u.pm * BM + ai * HALF + wr * 64 + m * 16 + fr; float ssq = 0.f;
#pragma unroll
                for (int n = 0; n < 2; ++n) { const int c0 = wc * 32 + n * 16 + fq * 4; const size_t i0 = (size_t)row * D + t * BM + c0, i1 = i0 + HALF;
                    const f32x4 h0 = *(const f32x4*)(res + i0) + acc[ai][0][m][n] * sc, h1 = *(const f32x4*)(res + i1) + acc[ai][1][m][n] * sc;
                    *(f32x4*)(H + i0) = h0; *(f32x4*)(H + i1) = h1; *(uint2*)(hb + i0) = pack4(h0); *(uint2*)(hb + i1) = pack4(h1);
                    ssq += (h0[0] * h0[0] + h0[1] * h0[1]) + (h0[2] * h0[2] + h0[3] * h0[3]) + (h1[0] * h1[0] + h1[1] * h1[1]) + (h1[2] * h1[2] + h1[3] * h1[3]); }
                ssq += __shfl_xor(ssq, 16); ssq += __shfl_xor(ssq, 32);
                if (fq == 0) ssout[(size_t)row * 16 + t * 4 + wc] = ssq;
                if (m == 3) asm volatile("" ::: "memory"); }
    }
    __device__ __forceinline__ void epi_ple(const f32x4 (&acc)[2][2][4][2], const Unit& u, int wr, int wc, int fr, int fq, int ui) const {
        float rs[8]; row_scales(rs, ui, wr, fr); const int t = u.pn;
#pragma unroll
        for (int ai = 0; ai < 2; ++ai)
#pragma unroll
            for (int m = 0; m < 4; ++m) { const int row = u.pm * BM + ai * HALF + wr * 64 + m * 16 + fr; float ssq = 0.f; const float r = rs[ai * 4 + m];
#pragma unroll
                for (int n = 0; n < 2; ++n) { const int c0 = wc * 32 + n * 16 + fq * 4; const size_t i0 = (size_t)row * D + t * BM + c0, i1 = i0 + HALF;
                    const f32x4 h0 = *(const f32x4*)(H + i0) + sigm4(acc[ai][0][m][n] * r) * *(const f32x4*)(pp + i0), h1 = *(const f32x4*)(H + i1) + sigm4(acc[ai][1][m][n] * r) * *(const f32x4*)(pp + i1);
                    *(f32x4*)(H + i0) = h0; *(f32x4*)(H + i1) = h1;
                    ssq += (h0[0] * h0[0] + h0[1] * h0[1]) + (h0[2] * h0[2] + h0[3] * h0[3]) + (h1[0] * h1[0] + h1[1] * h1[1]) + (h1[2] * h1[2] + h1[3] * h1[3]); }
                ssq += __shfl_xor(ssq, 16); ssq += __shfl_xor(ssq, 32);
                if (fq == 0) ssout[(size_t)row * 16 + t * 4 + wc] = ssq;
                if (m == 3) asm volatile("" ::: "memory"); }
    }
    __device__ __forceinline__ void epi_win(const f32x4 (&acc)[2][2][4][2], const Unit& u, int wr, int wc, int fr, int fq, int ui) const {
        float rs[8]; row_scales(rs, ui, wr, fr); const int t = u.pn;
        EPI_ROWS({ const float r = rs[ai * 4 + m]; const f32x4 a = acc[ai][0][m][n] * r, b = acc[ai][1][m][n] * r; const int d0 = n * 16 + fq * 4;
            if (t < 2 || t == 3 || t == 4) {
                const int head = 4 * (t < 2 ? t : t - 3) + wc;
                bf16_t* p = (t < 2 ? yb + (size_t)row * 1536 : iq + (size_t)row * 512) + head * 64 + d0;
                rope_store(p, p + 32, a, b, cs32 + (size_t)row * 64 + d0, cs32 + (size_t)row * 64 + 32 + d0);
            } else if (t == 2) {
                if (wc < 2) { bf16_t* p = (wc == 0 ? ak : ik) + (size_t)row * 64 + d0; rope_store(p, p + 32, a, b, cs32 + (size_t)row * 64 + d0, cs32 + (size_t)row * 64 + 32 + d0); }
                else { *(uint2*)(av + (size_t)row * 64 + (wc - 2) * 32 + d0) = pack4(a);
                       { bf16_t* tp = avt + ((size_t)(row >> 11) * 64 + (wc - 2) * 32 + d0) * SEQ + (row & 2047);
                         tp[0] = f2bf(a[0]); tp[SEQ] = f2bf(a[1]); tp[2 * SEQ] = f2bf(a[2]); tp[3 * SEQ] = f2bf(a[3]); }
                       if (wc == 2 && n == 0 && fq < 2) *(f32x4*)(iw + (size_t)row * 8 + fq * 4) = b; }
            } else if (t < 9) {
                const int head = 2 * (t < 7 ? t - 5 : t - 7) + (wc >> 1), d1 = (wc & 1) * 32 + d0;
                bf16_t* p = (t < 7 ? rq : rk) + (size_t)row * 512 + head * 128 + d1;
                rope_store(p, p + 64, a, b, cs64 + (size_t)row * 128 + d1, cs64 + (size_t)row * 128 + 64 + d1);
            } else if (t < 13) {
                bf16_t* p = rv + (size_t)row * 1024 + 256 * (t - 9) + c0; *(uint2*)p = pack4(a); *(uint2*)(p + HALF) = pack4(b);
            } else {
                bf16_t* p = yb + (size_t)row * 1536 + 512 + 256 * (t - 13) + c0; *(uint2*)p = pack4(silu4(a)); *(uint2*)(p + HALF) = pack4(silu4(b));
            } })
    }
#undef EPI_ROWS
    __device__ __forceinline__ void operator()(const f32x4 (&acc)[2][2][4][2], const Unit& u, int wr, int wc, int fr, int fq, int ui) const {
        if (kind == EK_GU) epi_gu(acc, u, wr, wc, fr, fq, ui);
        else if (kind == EK_RES) epi_res(acc, u, wr, wc, fr, fq, ui);
        else if (kind == EK_WIN) epi_win(acc, u, wr, wc, fr, fq, ui);
        else if (kind == EK_GATE) epi_gate(acc, u, wr, wc, fr, fq, ui);
        else if (kind == EK_BR) epi_br(acc, u, wr, wc, fr, fq, ui);
        else if (kind == EK_PP) epi_pp(acc, u, wr, wc, fr, fq, ui);
        else epi_ple(acc, u, wr, wc, fr, fq, ui);
    }
};

template <bool MID, class Epi, class Sched>
__device__ __forceinline__ void gemm_phase(PG8_LAS unsigned char* lds, const Gemm g, const Sched& S, const Epi& E, const int tid) {
    const int wid = __builtin_amdgcn_readfirstlane(tid >> 6), lane = tid & 63, wr = wid >> 2, wc = wid & 3, fr = lane & 15, fq = lane >> 4;
    const int K = g.K, nt = K / BK;
    unsigned voffA[2], voffB[2];
#pragma unroll
    for (int i = 0; i < 2; ++i) { int R, C; stage_rc(tid * 16 + i * 8192, R, C); voffA[i] = (unsigned)(R * K + C) * 2u; voffB[i] = voffA[i]; }
    const size_t kstep = (size_t)(BK * 2);
    const size_t hstep = (size_t)HALF * K * 2;
    const size_t tstep = 2 * hstep;
    const unsigned ldsw = (unsigned)wid * 1024u;
    const int aoff = lds_byte(wr * 64 + fr, fq * 8), boff = lds_byte(wc * 32 + fr, fq * 8);
#define PG8_SA(b, h) (((b) * 2 + (h)) * HTB)
#define PG8_SB(b, h) ((4 + (b) * 2 + (h)) * HTB)
#define PG8_STAGE(bufoff, gbase, voff) do { _Pragma("unroll") for (int _i = 0; _i < 2; ++_i) \
        __builtin_amdgcn_global_load_lds((const unsigned*)((const char*)(gbase) + (voff)[_i]), (PG8_LAS unsigned*)(lds + (bufoff) + ldsw + _i * 8192), 16, 0, 0); } while (0)
#define PG8_LDA(dst, b, h) do { _Pragma("unroll") for (int m = 0; m < 4; ++m) _Pragma("unroll") for (int k = 0; k < 2; ++k) dst[m][k] = *(const PG8_LAS bf16x8*)(lds + PG8_SA(b, h) + aoff + m * 2048 + k * 1024); } while (0)
#define PG8_LDB(dst, b, h) do { _Pragma("unroll") for (int n = 0; n < 2; ++n) _Pragma("unroll") for (int k = 0; k < 2; ++k) dst[n][k] = *(const PG8_LAS bf16x8*)(lds + PG8_SB(b, h) + boff + n * 2048 + k * 1024); } while (0)
#define PG8_MMA(ai, bj, At, Bt) do { __builtin_amdgcn_s_setprio(1); _Pragma("unroll") for (int m = 0; m < 4; ++m) _Pragma("unroll") for (int n = 0; n < 2; ++n) _Pragma("unroll") for (int k = 0; k < 2; ++k) \
        acc[ai][bj][m][n] = __builtin_amdgcn_mfma_f32_16x16x32_bf16(Bt[n][k], At[m][k], acc[ai][bj][m][n], 0, 0, 0); __builtin_amdgcn_s_setprio(0); } while (0)
#define PG8_WAIT_V(n) asm volatile("s_waitcnt vmcnt(" #n ")" ::: "memory")
#define PG8_WAIT_L(n) asm volatile("s_waitcnt lgkmcnt(" #n ")" ::: "memory")
#define PG8_BAR __builtin_amdgcn_s_barrier()
#define PG8_SCHED __builtin_amdgcn_sched_barrier(0)
    Unit cur, nxt; int ui = 0;
    if (!S.next(0, cur)) return;
    if (E.ss) {
        Unit tu; PG8_LAS float* tab = (PG8_LAS float*)E.rs_tab;
        for (int i = 0; S.next(i, tu); ++i) { const int row = tu.pm * BM + (tid >> 1);
            const f32x4 a = *(const f32x4*)(E.ss + (size_t)row * 16 + (tid & 1) * 8), b = *(const f32x4*)(E.ss + (size_t)row * 16 + (tid & 1) * 8 + 4);
            float s = ((a[0] + a[1]) + (a[2] + a[3])) + ((b[0] + b[1]) + (b[2] + b[3])); s += __shfl_xor(s, 1);
            if ((tid & 1) == 0) tab[i * 256 + (tid >> 1)] = rsqrtf(s * (1.f / 1024.f) + EPS); }
    }
    f32x4 acc[2][2][4][2];
#pragma unroll
    for (int a = 0; a < 2; ++a)
#pragma unroll
        for (int b = 0; b < 2; ++b)
#pragma unroll
            for (int m = 0; m < 4; ++m)
#pragma unroll
                for (int n = 0; n < 2; ++n) acc[a][b][m][n] = (f32x4){0.f, 0.f, 0.f, 0.f};
    bf16x8 At[4][2], B0[2][2], B1[2][2];
    const char* cA = (const char*)g.A + (size_t)cur.pm * tstep; const char* cB = (const char*)g.Bt + (size_t)cur.pn * tstep;
    PG8_STAGE(PG8_SB(0, 0), cB, voffB); PG8_STAGE(PG8_SB(0, 1), cB + hstep, voffB); PG8_STAGE(PG8_SA(0, 0), cA, voffA); PG8_STAGE(PG8_SA(0, 1), cA + hstep, voffA);
    if (wr == 1) PG8_BAR;
    PG8_WAIT_V(2); PG8_BAR;
    PG8_STAGE(PG8_SB(1, 0), cB + kstep, voffB); PG8_STAGE(PG8_SA(1, 0), cA + kstep, voffA); PG8_STAGE(PG8_SB(1, 1), cB + hstep + kstep, voffB);
    PG8_WAIT_V(6); PG8_BAR;
    for (;;) {
        const bool has_next = S.next(ui + 1, nxt);
        const char* nA = has_next ? (const char*)g.A + (size_t)nxt.pm * tstep : cA; const char* nB = has_next ? (const char*)g.Bt + (size_t)nxt.pn * tstep : cB;
#define PG8_KITER(t) do { \
            const bool last = ((t) == nt - 2); \
            const char* a1 = cA + (size_t)((t) + 1) * kstep; \
            const char* a2 = last ? nA : cA + (size_t)((t) + 2) * kstep; const char* b2 = last ? nB : cB + (size_t)((t) + 2) * kstep; \
            const char* a3 = a2 + kstep; const char* b3 = b2 + kstep; \
            PG8_LDB(B0, 0, 0); PG8_LDB(B1, 0, 1); PG8_SCHED; PG8_LDA(At, 0, 0); PG8_STAGE(PG8_SA(1, 1), a1 + hstep, voffA); \
            PG8_WAIT_V(8); PG8_WAIT_L(0); PG8_BAR; PG8_MMA(0, 0, At, B0); PG8_MMA(0, 1, At, B1); PG8_BAR; PG8_SCHED; \
            PG8_LDA(At, 0, 1); PG8_STAGE(PG8_SB(0, 0), b2, voffB); PG8_STAGE(PG8_SB(0, 1), b2 + hstep, voffB); PG8_STAGE(PG8_SA(0, 0), a2, voffA); \
            PG8_WAIT_V(8); PG8_WAIT_L(0); PG8_BAR; PG8_MMA(1, 0, At, B0); PG8_MMA(1, 1, At, B1); PG8_BAR; PG8_SCHED; \
            PG8_LDB(B0, 1, 0); PG8_LDB(B1, 1, 1); PG8_SCHED; PG8_LDA(At, 1, 0); PG8_STAGE(PG8_SA(0, 1), a2 + hstep, voffA); \
            PG8_WAIT_V(8); PG8_WAIT_L(0); PG8_BAR; PG8_MMA(0, 0, At, B0); PG8_MMA(0, 1, At, B1); PG8_BAR; PG8_SCHED; \
            PG8_LDA(At, 1, 1); PG8_STAGE(PG8_SB(1, 0), b3, voffB); PG8_STAGE(PG8_SB(1, 1), b3 + hstep, voffB); PG8_STAGE(PG8_SA(1, 0), a3, voffA); \
            PG8_WAIT_V(8); PG8_WAIT_L(0); PG8_BAR; PG8_MMA(1, 0, At, B0); PG8_MMA(1, 1, At, B1); PG8_BAR; PG8_SCHED; } while (0)
        if constexpr (MID) {
            const int tm = E.mid_t;
            for (int t = 0; t < tm; t += 2) PG8_KITER(t);
            E.mid(acc, cur, wr, wc, fr, fq);
            for (int t = tm; t < nt; t += 2) PG8_KITER(t);
        } else {
            for (int t = 0; t < nt; t += 2) PG8_KITER(t);
        }
        if (wr == 0) PG8_BAR;
        E(acc, cur, wr, wc, fr, fq, ui);
        if (!has_next) break;
#pragma unroll
        for (int a = 0; a < 2; ++a)
#pragma unroll
            for (int b = 0; b < 2; ++b)
#pragma unroll
                for (int m = 0; m < 4; ++m)
#pragma unroll
                    for (int n = 0; n < 2; ++n) acc[a][b][m][n] = (f32x4){0.f, 0.f, 0.f, 0.f};
        cur = nxt; cA = nA; cB = nB; ++ui;
        if (wr == 1) PG8_BAR;
    }
    PG8_WAIT_V(0);
    PG8_BAR;
#undef PG8_KITER
#undef PG8_SA
#undef PG8_SB
#undef PG8_STAGE
#undef PG8_LDA
#undef PG8_LDB
#undef PG8_MMA
#undef PG8_WAIT_V
#undef PG8_WAIT_L
#undef PG8_BAR
#undef PG8_SCHED
}
}

#define LAS __attribute__((address_space(3)))
#define XB_TMO      128
#define XB_XCNT(j)  (256  + 64 * (j))
#define XB_XSUB(j)  (1280 + 64 * (j))
#define XB_XGEN(j)  (2304 + 64 * (j))
#define XB_TOP      3328
#define XB_TOPGEN   3392
#define XCD_BAR_WORDS 3456
#define XB_SPIN_CAP (1u << 24)
__device__ __forceinline__ unsigned xb_ld(unsigned* p)              { return __hip_atomic_load(p, __ATOMIC_RELAXED, __HIP_MEMORY_SCOPE_AGENT); }
__device__ __forceinline__ unsigned xb_add(unsigned* p, unsigned v) { return __hip_atomic_fetch_add(p, v, __ATOMIC_RELAXED, __HIP_MEMORY_SCOPE_AGENT); }
__device__ __forceinline__ unsigned xb_xcc_id() { return (unsigned)__builtin_amdgcn_s_getreg((3 << 11) | 20) & 0xFu; }
#define XB_SPIN(cond, bar) do { unsigned _sp = 0; while (cond) { __builtin_amdgcn_s_sleep(1); \
    if ((++_sp & 255u) == 0u) { if (xb_ld(&(bar)[XB_TMO])) break; if (_sp > XB_SPIN_CAP) { atomicAdd(&(bar)[XB_TMO], 1u); break; } } } } while (0)
struct XcdBarrier { unsigned* bar; unsigned x; volatile LAS unsigned* st; };
__device__ __forceinline__ XcdBarrier xcd_barrier_post(unsigned* bar, volatile LAS unsigned* st, const int tid) {
    XcdBarrier b; b.bar = bar; b.x = xb_xcc_id(); b.st = st;
    if (tid == 0) (void)xb_add(&bar[XB_XCNT(b.x)], 1u);
    return b;
}
__device__ __forceinline__ void xcd_barrier_complete(unsigned* bar, unsigned x, unsigned& nloc, unsigned& nx) {
    const unsigned G = gridDim.x * gridDim.y * gridDim.z;
    unsigned sum, cnt, mine, sp = 0u;
    for (;;) {
        sum = 0u; cnt = 0u; mine = 0u;
#pragma unroll
        for (unsigned j = 0; j < 16; ++j) { const unsigned c = xb_ld(&bar[XB_XCNT(j)]); sum += c; cnt += (c > 0u) ? 1u : 0u; mine = (j == x) ? c : mine; }
        if (sum == G) break;
        __builtin_amdgcn_s_sleep(1);
        if ((++sp & 255u) == 0u) { if (xb_ld(&bar[XB_TMO])) break; if (sp > XB_SPIN_CAP) { atomicAdd(&bar[XB_TMO], 1u); break; } }
    }
    nloc = mine > 0u ? mine : 1u; nx = cnt > 0u ? cnt : 1u;
}
__device__ __forceinline__ void xcd_barrier(const XcdBarrier& b, const int tid) {
    asm volatile("s_waitcnt vmcnt(0)" ::: "memory");
    __syncthreads();
    if (tid == 0) {
        unsigned* bar = b.bar;
        __builtin_amdgcn_s_waitcnt(0);
        unsigned nloc = b.st[0], nx = b.st[1];
        if (nloc == 0u) { xcd_barrier_complete(bar, b.x, nloc, nx); b.st[0] = nloc; b.st[1] = nx; }
        const unsigned old = xb_add(&bar[XB_XSUB(b.x)], 1u);
        const unsigned gen = old / nloc;
        if (old + 1u == (gen + 1u) * nloc) {
            __builtin_amdgcn_fence(__ATOMIC_RELEASE, "agent");
            asm volatile("s_waitcnt vmcnt(0)" ::: "memory");
            const unsigned og = xb_add(&bar[XB_TOP], 1u);
            const unsigned tg = og / nx;
            if (og + 1u == (tg + 1u) * nx) xb_add(&bar[XB_TOPGEN], 1u);
            else XB_SPIN(xb_ld(&bar[XB_TOPGEN]) == tg, bar);
            __builtin_amdgcn_fence(__ATOMIC_ACQUIRE, "agent");
            xb_add(&bar[XB_XGEN(b.x)], 1u);
            asm volatile("s_waitcnt vmcnt(0)" ::: "memory");
        } else {
            XB_SPIN(xb_ld(&bar[XB_XGEN(b.x)]) == gen, bar);
            __builtin_amdgcn_fence(__ATOMIC_ACQUIRE, "agent");
            asm volatile("s_waitcnt vmcnt(0)" ::: "memory");
        }
    }
    __syncthreads();
}

template <class F> __device__ __forceinline__ void p0_item(const F& f, bf16_t* out, int ldo, int N, LAS float* scr, int item, int lane) {
    const int nblk = N / 32, kb = item / nblk, nb = item % nblk, k0 = 64 * kb, n0 = 32 * nb;
    f32x4 v[8];
#pragma unroll
    for (int i = 0; i < 8; ++i) v[i] = f.f4(n0 + 4 * (lane & 7), k0 + 8 * i + (lane >> 3));
#pragma unroll
    for (int i = 0; i < 8; ++i) { LAS float* d = scr + (8 * i + (lane >> 3)) * 33 + 4 * (lane & 7); d[0] = v[i][0]; d[1] = v[i][1]; d[2] = v[i][2]; d[3] = v[i][3]; }
    asm volatile("s_waitcnt lgkmcnt(0)" ::: "memory");
    const int c = lane & 7;
#pragma unroll
    for (int j = 0; j < 4; ++j) { const int n = (lane >> 3) + 8 * j; const LAS float* s = scr + (8 * c) * 33 + n;
        u32x4 o; o.x = pg8::cvt_pk_bf16(s[0 * 33], s[1 * 33]); o.y = pg8::cvt_pk_bf16(s[2 * 33], s[3 * 33]); o.z = pg8::cvt_pk_bf16(s[4 * 33], s[5 * 33]); o.w = pg8::cvt_pk_bf16(s[6 * 33], s[7 * 33]);
        *(u32x4*)(out + (size_t)(n0 + n) * ldo + k0 + 8 * c) = o; }
    asm volatile("s_waitcnt lgkmcnt(0)" ::: "memory");
}


__device__ __forceinline__ float dot64(const LAS float* q, const u32x4 (&kw)[8]) {
    float d = 0.f;
#pragma unroll
    for (int i8 = 0; i8 < 8; ++i8) { const u32x4 w = kw[i8]; const LAS float* qq = q + i8 * 8;
        d += (qq[0] * __uint_as_float(w.x << 16) + qq[1] * __uint_as_float(w.x & 0xffff0000u)) + (qq[2] * __uint_as_float(w.y << 16) + qq[3] * __uint_as_float(w.y & 0xffff0000u))
           + (qq[4] * __uint_as_float(w.z << 16) + qq[5] * __uint_as_float(w.z & 0xffff0000u)) + (qq[6] * __uint_as_float(w.w << 16) + qq[7] * __uint_as_float(w.w & 0xffff0000u)); }
    return d;
}
__device__ __forceinline__ void ld_k64(const bf16_t* kp, u32x4 (&kw)[8]) {
#pragma unroll
    for (int i = 0; i < 8; ++i) kw[i] = *(const u32x4*)(kp + 8 * i);
}
__device__ __forceinline__ int half_sum_i(int v, LAS int* red, int t) {
    int s = v;
#pragma unroll
    for (int o = 1; o < 64; o <<= 1) s += __shfl_xor(s, o);
    __syncthreads();
    if ((t & 63) == 0) red[t >> 6] = s;
    __syncthreads();
    return (red[0] + red[1]) + (red[2] + red[3]);
}
__device__ __forceinline__ float half_sum_f(float v, LAS float* red, int t) {
    const float s = wave_sum(v);
    __syncthreads();
    if ((t & 63) == 0) red[t >> 6] = s;
    __syncthreads();
    return (red[0] + red[1]) + (red[2] + red[3]);
}
__device__ __forceinline__ void mk_index_select(LAS unsigned char* l, int tok, int t, const bf16_t* IQ, const bf16_t* IK, const float* IW) {
    LAS float* q = (LAS float*)l; LAS float* w = (LAS float*)(l + 2048); LAS int* red = (LAS int*)(l + 2112); LAS unsigned* key = (LAS unsigned*)(l + 4096); LAS unsigned* msk = (LAS unsigned*)(l + 12288);
    const int b = tok >> 11, s = tok & 2047, L = ((s >> 6) + 1) << 6;
    __syncthreads();
#pragma unroll 1
    for (int i = t; i < 512; i += 256) q[i] = bf2f(IQ[(size_t)tok * 512 + i]);
    if (t < 8) w[t] = IW[(size_t)tok * 8 + t];
    if (t < 64) msk[t] = 0u;
    __syncthreads();
#pragma unroll 1
    for (int j = t; j < L; j += 256) {
        asm volatile("" ::: "memory");
        u32x4 kw[8]; ld_k64(IK + (size_t)(b * SEQ + j) * 64, kw);
        float sc = 0.f;
#pragma unroll 1
        for (int hh = 0; hh < 8; ++hh) { asm volatile("" ::: "memory"); sc += w[hh] * fmaxf(dot64(q + hh * 64, kw), 0.f); }
        sc += 0.f;
        unsigned u = __float_as_uint(sc); u ^= (u >> 31) ? 0xffffffffu : 0x80000000u;
        key[j] = u;
    }
    __syncthreads();
    if (L <= 256) {
#pragma unroll 1
        for (int j = t; j < L; j += 256) atomicOr((unsigned*)&msk[j >> 5], 1u << (j & 31)); }
    else {
        unsigned T = 0u;
#pragma unroll 1
        for (int bit = 31; bit >= 0; --bit) {
            const unsigned cand = T | (1u << bit); int c = 0;
#pragma unroll 1
            for (int j = t; j < L; j += 256) c += key[j] >= cand ? 1 : 0;
            if (half_sum_i(c, red, t) >= 256) T = cand;
        }
        int c = 0;
#pragma unroll 1
        for (int j = t; j < L; j += 256) { if (key[j] > T) { c++; atomicOr((unsigned*)&msk[j >> 5], 1u << (j & 31)); } }
        int need = 256 - half_sum_i(c, red, t);
        if (t == 0) {
#pragma unroll 1
            for (int j = 0; j < L && need > 0; ++j) if (key[j] == T) { msk[j >> 5] |= 1u << (j & 31); --need; } }
    }
    __syncthreads();
}
__device__ __forceinline__ void mk_attn_naive(LAS unsigned char* l, int tok, int t, bf16_t* YB, const bf16_t* AK, const bf16_t* AV) {
    LAS float* q = (LAS float*)l; LAS float* rinv = (LAS float*)(l + 2176); LAS unsigned* msk = (LAS unsigned*)(l + 12288); LAS float* lg = (LAS float*)(l + 16384);
    const int b = tok >> 11, s = tok & 2047, L = ((s >> 6) + 1) << 6, wid = t >> 6, lane = t & 63;
#pragma unroll 1
    for (int i = t; i < 512; i += 256) q[i] = bf2f(YB[(size_t)tok * 1536 + i]);
    __syncthreads();
#pragma unroll 1
    for (int hg = 0; hg < 2; ++hg) {
#pragma unroll 1
        for (int j = t; j < L; j += 256) {
            if ((msk[j >> 5] >> (j & 31)) & 1u) {
                asm volatile("" ::: "memory");
                u32x4 kw[8]; ld_k64(AK + (size_t)(b * SEQ + j) * 64, kw);
#pragma unroll 1
                for (int hh = 0; hh < 4; ++hh) { asm volatile("" ::: "memory"); lg[hh * 2048 + j] = dot64(q + (hg * 4 + hh) * 64, kw); }
            } else {
#pragma unroll
                for (int hh = 0; hh < 4; ++hh) lg[hh * 2048 + j] = -1e30f;
            }
        }
        __syncthreads();
        {
            float m = -1e30f;
#pragma unroll 1
            for (int j = lane; j < L; j += 64) m = fmaxf(m, lg[wid * 2048 + j]);
            m = wave_max(m);
            float sum = 0.f;
#pragma unroll 1
            for (int j = lane; j < L; j += 64) { const float x = lg[wid * 2048 + j]; const float p = x > -5e29f ? __expf(x - m) : 0.f; lg[wid * 2048 + j] = p; sum += p; }
            sum = wave_sum(sum);
            if (lane == 0) rinv[wid] = 1.f / sum;
        }
        __syncthreads();
        {
            float o = 0.f;
#pragma unroll 1
            for (int j = 0; j < L; ++j) { const float p = lg[wid * 2048 + j]; if (p != 0.f) o += p * bf2f(AV[(size_t)(b * SEQ + j) * 64 + lane]); }
            YB[(size_t)tok * 1536 + (hg * 4 + wid) * 64 + lane] = f2bf(o * rinv[wid]);
        }
        __syncthreads();
    }
}
__device__ __forceinline__ void mk_ret_naive(LAS unsigned char* l, int tok, int h, int t, const bf16_t* RQ, const bf16_t* RK, const bf16_t* RV, bf16_t* YB) {
    LAS float* q = (LAS float*)l; LAS float* sc = (LAS float*)(l + 1024); LAS float* red = (LAS float*)(l + 2112);
    const int b = tok >> 11, s = tok & 2047, L = ((s >> 6) + 1) << 6;
    __syncthreads();
    if (t < 128) q[t] = bf2f(RQ[(size_t)tok * 512 + h * 128 + t]);
    __syncthreads();
    const float lg2 = log2f(1.f - exp2f(-5.f - (float)h));
    float y = 0.f;
#pragma unroll 1
    for (int j0 = 0; j0 < L; j0 += 256) {
        const int j = j0 + t; float sv = 0.f;
        if (j < L) {
            const bf16_t* kr = RK + (size_t)(b * SEQ + j) * 512 + h * 128;
            asm volatile("" ::: "memory");
            float d; { u32x4 kw[8]; ld_k64(kr, kw); d = dot64(q, kw); } { u32x4 kw[8]; ld_k64(kr + 64, kw); d += dot64(q + 64, kw); }
            const int dist = s > j ? s - j : j - s;
            sv = d * exp2f(lg2 * (float)dist);
        }
        sc[t] = sv;
        __syncthreads();
        const int n = (L - j0) < 256 ? (L - j0) : 256;
#pragma unroll 1
        for (int jj = 0; jj < n; ++jj) y += sc[jj] * bf2f(RV[(size_t)(b * SEQ + j0 + jj) * 1024 + h * 256 + t]);
        __syncthreads();
    }
    const float mean = half_sum_f(y, red, t) * (1.f / 256.f);
    const float dv = y - mean;
    const float var = half_sum_f(dv * dv, red, t) * (1.f / 256.f);
    const float yn = dv * rsqrtf(var + GN_EPS);
    bf16_t* o = YB + (size_t)tok * 1536 + 512 + h * 256 + t;
    *o = f2bf(yn * bf2f(*o));
}

__device__ __forceinline__ int lane_now() { int l; asm volatile("v_mbcnt_lo_u32_b32 %0, -1, 0\n\tv_mbcnt_hi_u32_b32 %0, -1, %0" : "=v"(l)); return l; }
__device__ __forceinline__ unsigned mono_key(float s) { const unsigned u = __float_as_uint(s); return u ^ ((unsigned)((int)u >> 31) | 0x80000000u); }
__device__ __forceinline__ int crow16(int r, int hf) { return (r & 3) + 8 * (r >> 2) + 4 * hf; }
typedef short s16x4_t __attribute__((ext_vector_type(4)));
__device__ __forceinline__ s16x4_t lds_tr16(const LAS unsigned char* p) { return __builtin_bit_cast(s16x4_t, __builtin_amdgcn_ds_read_tr16_b64_v4i16((LAS s16x4_t*)p)); }
__device__ __forceinline__ bf16x8 cat8(s16x4_t lo, s16x4_t hi) { bf16x8 r; r[0] = lo[0]; r[1] = lo[1]; r[2] = lo[2]; r[3] = lo[3]; r[4] = hi[0]; r[5] = hi[1]; r[6] = hi[2]; r[7] = hi[3]; return r; }
__device__ __forceinline__ int row16_sum(int x) {
    x += __builtin_amdgcn_update_dpp(0, x, 0xB1, 0xF, 0xF, true);
    x += __builtin_amdgcn_update_dpp(0, x, 0x4E, 0xF, 0xF, true);
    x += __builtin_amdgcn_update_dpp(0, x, 0x141, 0xF, 0xF, true);
    x += __builtin_amdgcn_update_dpp(0, x, 0x140, 0xF, 0xF, true);
    return x;
}
__device__ __forceinline__ void dsa_unit(LAS unsigned char* lds, int b, int g, const bf16_t* IQ, const bf16_t* IK, const float* IW, bf16_t* YB, const bf16_t* AK, const bf16_t* AV, const int w, const bool do_store = true) {
    const int lane = lane_now(), c = lane & 31, hf = lane >> 5, tid = w * 64 + lane;
    const int tok0 = b * SEQ + 32 * g + 4 * w;
    const int nt = 2 * (g >> 1) + 2, nst = nt >> 1;
    constexpr int RS = 144;
    LAS unsigned* MSK = (LAS unsigned*)lds + w * 256;
    LAS float* wsf = (LAS float*)(lds + 8192) + w * 64;
    LAS unsigned char* KB = lds + 16384; LAS unsigned char* VB = lds + 34816;
    const int srow = tid >> 3, sch = tid & 7;
    unsigned k0[64], k1[64];
    {
        const int ql = 2 * ((c >> 2) & 1) + (c >> 4), head = (c & 3) + 4 * ((c >> 3) & 1);
        bf16x8 aI[4];
#pragma unroll
        for (int s = 0; s < 4; ++s) aI[s] = *(const bf16x8*)(IQ + (size_t)(tok0 + ql) * 512 + head * 64 + 16 * s + 8 * hf);
        const f32x4 wa = *(const f32x4*)(IW + (size_t)(tok0 + 2 * hf) * 8), wb = *(const f32x4*)(IW + (size_t)(tok0 + 2 * hf) * 8 + 4);
        const f32x4 wc4 = *(const f32x4*)(IW + (size_t)(tok0 + 2 * hf + 1) * 8), wd = *(const f32x4*)(IW + (size_t)(tok0 + 2 * hf + 1) * 8 + 4);
        const bf16_t* gsrc = IK + ((size_t)b * SEQ + srow) * 64 + sch * 8;
        u32x4 rkr[2];
        rkr[0] = *(const u32x4*)gsrc;
        if (1 < nst) rkr[1] = *(const u32x4*)(gsrc + (size_t)4096);
        *(LAS u32x4*)(KB + srow * RS + sch * 16) = rkr[0];
        if (2 < nst) rkr[0] = *(const u32x4*)(gsrc + (size_t)2 * 4096);
        __syncthreads();
#define DSA_SCORE(bufoff, sub, j) do { f32x16 acc; _Pragma("unroll") for (int r = 0; r < 16; ++r) acc[r] = 0.f; \
            _Pragma("unroll") for (int s = 0; s < 4; ++s) acc = __builtin_amdgcn_mfma_f32_32x32x16_bf16(aI[s], *(const LAS bf16x8*)(KB + (bufoff) + (32 * (sub) + c) * RS + (16 * s + 8 * hf) * 2), acc, 0, 0, 0); \
            float s0 = 0.f, s1 = 0.f; \
            _Pragma("unroll") for (int r = 0; r < 4; ++r) { s0 = fmaf(wa[r], fmaxf(acc[r], 0.f), s0); s1 = fmaf(wc4[r], fmaxf(acc[8 + r], 0.f), s1); } \
            _Pragma("unroll") for (int r = 0; r < 4; ++r) { s0 = fmaf(wb[r], fmaxf(acc[4 + r], 0.f), s0); s1 = fmaf(wd[r], fmaxf(acc[12 + r], 0.f), s1); } \
            k0[j] = mono_key(s0); k1[j] = mono_key(s1); } while (0)
#pragma unroll
        for (int st = 0; st < 32; ++st) {
            if (st < nst) {
                DSA_SCORE((st & 1) * 9216, 0, 2 * st);
                DSA_SCORE((st & 1) * 9216, 1, 2 * st + 1);
                if (st + 1 < nst) *(LAS u32x4*)(KB + ((st + 1) & 1) * 9216 + srow * RS + sch * 16) = rkr[(st + 1) & 1];
                if (st + 3 < nst) rkr[(st + 1) & 1] = *(const u32x4*)(gsrc + (size_t)(st + 3) * 4096);
                __syncthreads();
            } else { k0[2 * st] = 0u; k1[2 * st] = 0u; k0[2 * st + 1] = 0u; k1[2 * st + 1] = 0u; }
        }
#undef DSA_SCORE
    }
    unsigned T0 = 1u, T1 = 1u;
    if (nt > 8) {
        T0 = 0u; T1 = 0u; bool d0 = false, d1 = false;
        for (int bit = 31; bit >= 0; --bit) {
            const unsigned c0 = T0 | (1u << bit), c1 = T1 | (1u << bit); int n0 = 0, n1 = 0;
#pragma unroll
            for (int j8 = 0; j8 < 8; ++j8) { if (8 * j8 < nt) {
#pragma unroll
                for (int j = 8 * j8; j < 8 * j8 + 8; ++j) { n0 += (k0[j] >= c0) ? 1 : 0; n1 += (k1[j] >= c1) ? 1 : 0; } } }
            n0 = row16_sum(n0); n1 = row16_sum(n1);
            n0 += __shfl_xor(n0, 16); n1 += __shfl_xor(n1, 16);
            if (!d0 && n0 >= 256) T0 = c0;
            if (!d1 && n1 >= 256) T1 = c1;
            d0 = d0 || (n0 == 256); d1 = d1 || (n1 == 256);
            if (__all(d0 && d1)) break;
        }
    }
#pragma unroll
    for (int j = 0; j < 64; ++j) {
        if (j < nt) {
            const unsigned long long m0 = __ballot(k0[j] >= T0), m1 = __ballot(k1[j] >= T1);
            if (lane == 0) { MSK[0 * 64 + j] = (unsigned)m0; MSK[2 * 64 + j] = (unsigned)(m0 >> 32); MSK[1 * 64 + j] = (unsigned)m1; MSK[3 * 64 + j] = (unsigned)(m1 >> 32); }
        }
    }
    asm volatile("s_waitcnt lgkmcnt(0)" ::: "memory");
    {
        const int lane2 = lane_now(), c = lane2 & 31, hf = lane2 >> 5;
        const int trq = (lane2 & 15) >> 2, trp = lane2 & 3, trblk = (lane2 >> 4) & 1;
        bf16x8 bQ[4];
        { const bf16_t* qp = YB + (size_t)(tok0 + (c >> 3)) * 1536 + (c & 7) * 64 + 8 * hf;
#pragma unroll
          for (int s = 0; s < 4; ++s) bQ[s] = *(const bf16x8*)(qp + 16 * s); }
        f32x16 O0, O1;
#pragma unroll
        for (int r = 0; r < 16; ++r) { O0[r] = 0.f; O1[r] = 0.f; }
        float m_run = 0.f, l_run = 0.f; bool seen = false;
        const bf16_t* ksrc = AK + ((size_t)b * SEQ + srow) * 64 + sch * 8;
        const bf16_t* vsrc = AV + ((size_t)b * SEQ + srow) * 64 + sch * 8;
        const LAS unsigned* mrow = MSK + (c >> 3) * 64;
        LAS unsigned char* K2 = lds + 16384; LAS unsigned char* V2 = lds + 53248;
        const int nst4 = (nt + 3) >> 2;
        u32x4 rk0 = *(const u32x4*)ksrc, rk1 = *(const u32x4*)(ksrc + 4096), rv0 = *(const u32x4*)vsrc, rv1 = *(const u32x4*)(vsrc + 4096);
        __syncthreads();
        *(LAS u32x4*)(K2 + srow * RS + sch * 16) = rk0; *(LAS u32x4*)(K2 + (srow + 64) * RS + sch * 16) = rk1;
        *(LAS u32x4*)(V2 + srow * RS + sch * 16) = rv0; *(LAS u32x4*)(V2 + (srow + 64) * RS + sch * 16) = rv1;
        __syncthreads();
        for (int st = 0; st < nst4; ++st) {
            const int bo = (st & 1) * 18432;
            if (st + 1 < nst4) { const size_t go = (size_t)(st + 1) * 8192; rk0 = *(const u32x4*)(ksrc + go); rk1 = *(const u32x4*)(ksrc + go + 4096); rv0 = *(const u32x4*)(vsrc + go); rv1 = *(const u32x4*)(vsrc + go + 4096); }
#pragma unroll
            for (int sub = 0; sub < 4; ++sub) {
                const int j = 4 * st + sub;
                if (j < nt) {
                f32x16 S;
#pragma unroll
                for (int r = 0; r < 16; ++r) S[r] = -m_run;
#pragma unroll
                for (int s = 0; s < 4; ++s) S = __builtin_amdgcn_mfma_f32_32x32x16_bf16(*(const LAS bf16x8*)(K2 + bo + (32 * sub + c) * RS + (16 * s + 8 * hf) * 2), bQ[s], S, 0, 0, 0);
                bf16x8 bV[2][2];
#pragma unroll
                for (int s = 0; s < 2; ++s)
#pragma unroll
                    for (int dh = 0; dh < 2; ++dh) { const LAS unsigned char* p = V2 + bo + (32 * sub + 16 * s + 4 * hf + trq) * RS + (32 * dh + 16 * trblk + 4 * trp) * 2;
                        bV[s][dh] = cat8(lds_tr16(p), lds_tr16(p + 8 * RS)); }
                const unsigned mw = mrow[j] >> (4 * hf);
                float rowmax = -1e30f;
#pragma unroll
                for (int r = 0; r < 16; ++r) { S[r] = __builtin_amdgcn_sbfe(mw, (r & 3) + 8 * (r >> 2), 1) ? S[r] : -1e30f; rowmax = fmaxf(rowmax, S[r]); }
                rowmax = fmaxf(rowmax, __shfl_xor(rowmax, 32));
                const bool has = rowmax > -1e29f;
                if (__any(rowmax > 8.f || (has && !seen))) {
                    const float dl = seen ? fmaxf(rowmax, 0.f) : (has ? rowmax : 0.f), alpha = seen ? __builtin_amdgcn_exp2f(-dl) : 1.f;
                    seen = seen || has;
                    m_run += dl; l_run *= alpha;
#pragma unroll
                    for (int r = 0; r < 16; ++r) S[r] -= dl;
                    if (hf == 0) wsf[c] = alpha;
                    asm volatile("s_waitcnt lgkmcnt(0)" ::: "memory");
#pragma unroll
                    for (int r = 0; r < 16; ++r) { const float a_ = wsf[crow16(r, hf)]; O0[r] *= a_; O1[r] *= a_; }
                    asm volatile("s_waitcnt lgkmcnt(0)" ::: "memory");
                }
                float psum = 0.f;
#pragma unroll
                for (int r = 0; r < 16; ++r) { S[r] = __builtin_amdgcn_exp2f(S[r]); psum += S[r]; }
                l_run += psum;
#pragma unroll
                for (int s = 0; s < 2; ++s) {
                    u32x4 pw; pw.x = pg8::cvt_pk_bf16(S[8 * s + 0], S[8 * s + 1]); pw.y = pg8::cvt_pk_bf16(S[8 * s + 2], S[8 * s + 3]); pw.z = pg8::cvt_pk_bf16(S[8 * s + 4], S[8 * s + 5]); pw.w = pg8::cvt_pk_bf16(S[8 * s + 6], S[8 * s + 7]);
                    const bf16x8 pa = __builtin_bit_cast(bf16x8, pw);
                    O0 = __builtin_amdgcn_mfma_f32_32x32x16_bf16(pa, bV[s][0], O0, 0, 0, 0);
                    O1 = __builtin_amdgcn_mfma_f32_32x32x16_bf16(pa, bV[s][1], O1, 0, 0, 0);
                }
                }
            }
            if (st + 1 < nst4) { const int bn = bo ^ 18432;
                *(LAS u32x4*)(K2 + bn + srow * RS + sch * 16) = rk0; *(LAS u32x4*)(K2 + bn + (srow + 64) * RS + sch * 16) = rk1;
                *(LAS u32x4*)(V2 + bn + srow * RS + sch * 16) = rv0; *(LAS u32x4*)(V2 + bn + (srow + 64) * RS + sch * 16) = rv1; }
            __syncthreads();
        }
        const float l_tot = l_run + __shfl_xor(l_run, 32);
        if (hf == 0) wsf[c] = 1.f / l_tot;
        asm volatile("s_waitcnt lgkmcnt(0)" ::: "memory");
#pragma unroll
        for (int r = 0; r < 16; ++r) { const int cc = crow16(r, hf); const float inv = wsf[cc];
            bf16_t* o = YB + (size_t)(tok0 + (cc >> 3)) * 1536 + (cc & 7) * 64 + c;
            if (do_store) { o[0] = f2bf(O0[r] * inv); o[32] = f2bf(O1[r] * inv); } else { asm volatile("" :: "v"(O0[r] * inv), "v"(O1[r] * inv)); } }
        asm volatile("s_waitcnt lgkmcnt(0)" ::: "memory");
    }
}

__device__ __forceinline__ void ret_item(LAS unsigned char* lds, int b, int h, const bf16_t* RQ, const bf16_t* RK, const bf16_t* RV, bf16_t* YB, const int w, const int n1, const int nf, const bool do_store = true) {
    const int lane = lane_now(), c = lane & 31, hf = lane >> 5, tid = w * 64 + lane;
    constexpr int QS = 272, VS = 528, PS = 144, YSF = 260;
    LAS unsigned char *QI = lds, *KI = lds + 17408, *KD = lds + 34816, *VI = lds + 52224, *PI = lds + 86016; LAS float* YBUF = (LAS float*)lds;
    const float lg2 = log2f(1.f - exp2f(-5.f - (float)h)), g64 = exp2f(lg2 * 64.f);
    const float kf0 = exp2f(lg2 * (float)(63 - (tid >> 4))), kf1 = exp2f(lg2 * (float)(63 - ((tid + 512) >> 4)));
    const int trq = (lane & 15) >> 2, trp = lane & 3, trblk = (lane >> 4) & 1;
    f32x16 S[4];
#pragma unroll
    for (int d = 0; d < 4; ++d)
#pragma unroll
        for (int r = 0; r < 16; ++r) S[d][r] = 0.f;
    u32x4 rq[2], rk[2], rv[4], rg[4];
    const size_t tb0 = (size_t)b * SEQ;
#define RET_LOAD(n) do { const size_t tb = tb0 + 64 * (n); \
        _Pragma("unroll") for (int k = 0; k < 2; ++k) { const int p = tid + 512 * k, row = p >> 4, ch = p & 15; \
            rq[k] = *(const u32x4*)(RQ + (tb + row) * 512 + h * 128 + ch * 8); rk[k] = *(const u32x4*)(RK + (tb + row) * 512 + h * 128 + ch * 8); } \
        _Pragma("unroll") for (int k = 0; k < 4; ++k) { const int p = tid + 512 * k, row = p >> 5, ch = p & 31; rv[k] = *(const u32x4*)(RV + (tb + row) * 1024 + h * 256 + ch * 8); } } while (0)
    if (nf > 0) {
#define RET_LOADKV(n) do { const size_t tb = tb0 + 64 * (n); \
        _Pragma("unroll") for (int k = 0; k < 2; ++k) { const int p = tid + 512 * k, row = p >> 4, ch = p & 15; rk[k] = *(const u32x4*)(RK + (tb + row) * 512 + h * 128 + ch * 8); } \
        _Pragma("unroll") for (int k = 0; k < 4; ++k) { const int p = tid + 512 * k, row = p >> 5, ch = p & 31; rv[k] = *(const u32x4*)(RV + (tb + row) * 1024 + h * 256 + ch * 8); } } while (0)
        RET_LOADKV(0);
        for (int n = 0; n < nf; ++n) {
#pragma unroll
            for (int k = 0; k < 2; ++k) { const int p = tid + 512 * k, row = p >> 4, ch = p & 15; const float f = k == 0 ? kf0 : kf1; u32x4 kd; const u32x4 kk = rk[k];
                kd.x = pg8::cvt_pk_bf16(__uint_as_float(kk.x << 16) * f, __uint_as_float(kk.x & 0xffff0000u) * f); kd.y = pg8::cvt_pk_bf16(__uint_as_float(kk.y << 16) * f, __uint_as_float(kk.y & 0xffff0000u) * f);
                kd.z = pg8::cvt_pk_bf16(__uint_as_float(kk.z << 16) * f, __uint_as_float(kk.z & 0xffff0000u) * f); kd.w = pg8::cvt_pk_bf16(__uint_as_float(kk.w << 16) * f, __uint_as_float(kk.w & 0xffff0000u) * f);
                *(LAS u32x4*)(KD + row * QS + ch * 16) = kd; }
#pragma unroll
            for (int k = 0; k < 4; ++k) { const int p = tid + 512 * k, row = p >> 5, ch = p & 31; *(LAS u32x4*)(VI + row * VS + ch * 16) = rv[k]; }
            __syncthreads();
            if (n + 1 < nf) RET_LOADKV(n + 1);
            bf16x8 bV[4];
#pragma unroll
            for (int s = 0; s < 4; ++s) { const LAS unsigned char* p = VI + (16 * s + 8 * hf + trq) * VS + (32 * w + 16 * trblk + 4 * trp) * 2; bV[s] = cat8(lds_tr16(p), lds_tr16(p + 4 * VS)); }
#pragma unroll
            for (int dt = 0; dt < 4; ++dt) {
#pragma unroll
                for (int r = 0; r < 16; ++r) S[dt][r] *= g64;
#pragma unroll
                for (int s = 0; s < 4; ++s) { const LAS unsigned char* p = KD + (16 * s + 8 * hf + trq) * QS + (32 * dt + 16 * trblk + 4 * trp) * 2;
                    S[dt] = __builtin_amdgcn_mfma_f32_32x32x16_bf16(cat8(lds_tr16(p), lds_tr16(p + 4 * QS)), bV[s], S[dt], 0, 0, 0); }
            }
            __syncthreads();
        }
#undef RET_LOADKV
    }
    RET_LOAD(nf);
    for (int n = nf; n < n1; ++n) {
        constexpr bool full = true;
#pragma unroll
        for (int k = 0; k < 2; ++k) { const int p = tid + 512 * k, row = p >> 4, ch = p & 15;
            *(LAS u32x4*)(QI + row * QS + ch * 16) = rq[k]; *(LAS u32x4*)(KI + row * QS + ch * 16) = rk[k];
            const float f = k == 0 ? kf0 : kf1; u32x4 kd; const u32x4 kk = rk[k];
            kd.x = pg8::cvt_pk_bf16(__uint_as_float(kk.x << 16) * f, __uint_as_float(kk.x & 0xffff0000u) * f); kd.y = pg8::cvt_pk_bf16(__uint_as_float(kk.y << 16) * f, __uint_as_float(kk.y & 0xffff0000u) * f);
            kd.z = pg8::cvt_pk_bf16(__uint_as_float(kk.z << 16) * f, __uint_as_float(kk.z & 0xffff0000u) * f); kd.w = pg8::cvt_pk_bf16(__uint_as_float(kk.w << 16) * f, __uint_as_float(kk.w & 0xffff0000u) * f);
            *(LAS u32x4*)(KD + row * QS + ch * 16) = kd; }
#pragma unroll
        for (int k = 0; k < 4; ++k) { const int p = tid + 512 * k, row = p >> 5, ch = p & 31; *(LAS u32x4*)(VI + row * VS + ch * 16) = rv[k]; }
        __syncthreads();
        if (n + 1 < n1) RET_LOAD(n + 1);
        bf16x8 bV[4];
#pragma unroll
        for (int s = 0; s < 4; ++s) { const LAS unsigned char* p = VI + (16 * s + 8 * hf + trq) * VS + (32 * w + 16 * trblk + 4 * trp) * 2;
            bV[s] = cat8(lds_tr16(p), lds_tr16(p + 4 * VS)); }
        if (full && w < 4) { const int jt = w & 1, it = w >> 1; f32x16 X;
#pragma unroll
            for (int r = 0; r < 16; ++r) X[r] = 0.f;
#pragma unroll
            for (int s = 0; s < 8; ++s) { const bf16x8 a = *(const LAS bf16x8*)(KI + (32 * jt + c) * QS + (16 * s + 8 * hf) * 2), bq = *(const LAS bf16x8*)(QI + (32 * it + c) * QS + (16 * s + 8 * hf) * 2);
                X = __builtin_amdgcn_mfma_f32_32x32x16_bf16(a, bq, X, 0, 0, 0); }
#pragma unroll
            for (int g4 = 0; g4 < 4; ++g4) { f32x4 v;
#pragma unroll
                for (int k = 0; k < 4; ++k) { const int i = 32 * it + c, j = 32 * jt + 8 * g4 + 4 * hf + k; const int dist = i > j ? i - j : j - i; v[k] = X[4 * g4 + k] * __builtin_amdgcn_exp2f(lg2 * (float)dist); }
                { const uint2 pk = pg8::pack4(v); u32x2 pw; pw.x = pk.x; pw.y = pk.y; *(LAS u32x2*)(PI + (32 * it + c) * PS + (32 * jt + 8 * g4 + 4 * hf) * 2) = pw; } }
        }
        f32x16 Y[2];
#pragma unroll
        for (int it = 0; it < 2; ++it)
#pragma unroll
            for (int r = 0; r < 16; ++r) Y[it][r] = 0.f;
        if (full) {
#pragma unroll
        for (int dt = 0; dt < 4; ++dt)
#pragma unroll
            for (int sp = 0; sp < 2; ++sp) {
                u32x4 sw; sw.x = pg8::cvt_pk_bf16(S[dt][8 * sp + 0], S[dt][8 * sp + 1]); sw.y = pg8::cvt_pk_bf16(S[dt][8 * sp + 2], S[dt][8 * sp + 3]); sw.z = pg8::cvt_pk_bf16(S[dt][8 * sp + 4], S[dt][8 * sp + 5]); sw.w = pg8::cvt_pk_bf16(S[dt][8 * sp + 6], S[dt][8 * sp + 7]);
                const bf16x8 bS = __builtin_bit_cast(bf16x8, sw);
#pragma unroll
                for (int it = 0; it < 2; ++it) { const LAS unsigned char* p = QI + (32 * it + c) * QS + (32 * dt + 16 * sp + 4 * hf) * 2;
                    const u32x2 lo = *(const LAS u32x2*)p, hi = *(const LAS u32x2*)(p + 16); u32x4 aw; aw.x = lo.x; aw.y = lo.y; aw.z = hi.x; aw.w = hi.y;
                    Y[it] = __builtin_amdgcn_mfma_f32_32x32x16_bf16(__builtin_bit_cast(bf16x8, aw), bS, Y[it], 0, 0, 0); }
            }
#pragma unroll
        for (int it = 0; it < 2; ++it)
#pragma unroll
            for (int r = 0; r < 16; ++r) Y[it][r] *= __builtin_amdgcn_exp2f(lg2 * (float)(32 * it + crow16(r, hf) + 1));
        __syncthreads();
#pragma unroll
        for (int it = 0; it < 2; ++it)
#pragma unroll
            for (int s = 0; s < 4; ++s) { const bf16x8 a = *(const LAS bf16x8*)(PI + (32 * it + c) * PS + (16 * s + 8 * hf) * 2); Y[it] = __builtin_amdgcn_mfma_f32_32x32x16_bf16(a, bV[s], Y[it], 0, 0, 0); }
        }
#pragma unroll
        for (int dt = 0; dt < 4; ++dt) {
#pragma unroll
            for (int r = 0; r < 16; ++r) S[dt][r] *= g64;
#pragma unroll
            for (int s = 0; s < 4; ++s) { const LAS unsigned char* p = KD + (16 * s + 8 * hf + trq) * QS + (32 * dt + 16 * trblk + 4 * trp) * 2;
                S[dt] = __builtin_amdgcn_mfma_f32_32x32x16_bf16(cat8(lds_tr16(p), lds_tr16(p + 4 * QS)), bV[s], S[dt], 0, 0, 0); }
        }
        __syncthreads();
        if (full) {
        {
            const bf16_t* gp = YB + (tb0 + 64 * n + (tid >> 3)) * 1536 + 512 + h * 256 + (tid & 7) * 32;
#pragma unroll
            for (int k = 0; k < 4; ++k) rg[k] = *(const u32x4*)(gp + 8 * k);
        }
#pragma unroll
        for (int it = 0; it < 2; ++it)
#pragma unroll
            for (int r = 0; r < 16; ++r) YBUF[(32 * it + crow16(r, hf)) * YSF + 32 * w + c] = Y[it][r];
        __syncthreads();
        {
            const int i = tid >> 3, seg = tid & 7; const LAS f32x4* yp = (const LAS f32x4*)(YBUF + i * YSF + seg * 32);
            f32x4 y[8]; float s1 = 0.f;
#pragma unroll
            for (int k = 0; k < 8; ++k) { y[k] = yp[k]; s1 += (y[k][0] + y[k][1]) + (y[k][2] + y[k][3]); }
            s1 += __shfl_xor(s1, 1); s1 += __shfl_xor(s1, 2); s1 += __shfl_xor(s1, 4);
            const float mean = s1 * (1.f / 256.f); float s2 = 0.f;
#pragma unroll
            for (int k = 0; k < 8; ++k) { y[k] = y[k] - mean; s2 += (y[k][0] * y[k][0] + y[k][1] * y[k][1]) + (y[k][2] * y[k][2] + y[k][3] * y[k][3]); }
            s2 += __shfl_xor(s2, 1); s2 += __shfl_xor(s2, 2); s2 += __shfl_xor(s2, 4);
            const float rstd = rsqrtf(s2 * (1.f / 256.f) + GN_EPS);
            bf16_t* op = YB + (tb0 + 64 * n + i) * 1536 + 512 + h * 256 + seg * 32;
#pragma unroll
            for (int k = 0; k < 4; ++k) { const u32x4 gq = rg[k]; const f32x4 ya = y[2 * k] * rstd, yb2 = y[2 * k + 1] * rstd; u32x4 o;
                o.x = pg8::cvt_pk_bf16(ya[0] * __uint_as_float(gq.x << 16), ya[1] * __uint_as_float(gq.x & 0xffff0000u)); o.y = pg8::cvt_pk_bf16(ya[2] * __uint_as_float(gq.y << 16), ya[3] * __uint_as_float(gq.y & 0xffff0000u));
                o.z = pg8::cvt_pk_bf16(yb2[0] * __uint_as_float(gq.z << 16), yb2[1] * __uint_as_float(gq.z & 0xffff0000u)); o.w = pg8::cvt_pk_bf16(yb2[2] * __uint_as_float(gq.w << 16), yb2[3] * __uint_as_float(gq.w & 0xffff0000u));
                if (do_store) *(u32x4*)(op + 8 * k) = o; else asm volatile("" :: "v"(o.x), "v"(o.y), "v"(o.z), "v"(o.w)); }
        }
        __syncthreads();
        }
    }
#undef RET_LOAD
}

constexpr int CV_I_GU = (D / 64) * (2 * FF / 32), CV_I_D = (FF / 64) * (D / 32), CV_I_GATE = (D / 64) * (2048 / 32), CV_I_A = (512 / 64) * (D / 32), CV_I_SQ = (D / 64) * (D / 32), CV_I_PP = (256 / 64) * (D / 32);
constexpr int CV_NITEMS = CV_I_GU + CV_I_D + CV_I_GATE + CV_I_A + 3 * CV_I_SQ + CV_I_PP, NCONV = CV_NITEMS / 32, CV_PROWS = 147;
static_assert(CV_NITEMS % 32 == 0 && NCONV * CV_PROWS >= M, "deferred conversion tickets");
__device__ __forceinline__ void conv_ticket(LAS unsigned char* lds, unsigned char* ws, const float* const* in, int cv, int wave, int lane) {
    LAS float* scr = (LAS float*)(lds + wave * 16384);
#pragma unroll 1
    for (int q = 0; q < 4; ++q) {
        int r = cv * 32 + q * 8 + wave;
        if (r < CV_I_GU) { p0_item(SrcGU{in[14], in[15], in[13]}, (bf16_t*)(ws + WS_WGU2), 1024, 2 * FF, scr, r, lane); continue; } r -= CV_I_GU;
        if (r < CV_I_D) { p0_item(SrcPlain{in[16], nullptr, 1024, 1.f}, (bf16_t*)(ws + WS_WD2), FF, D, scr, r, lane); continue; } r -= CV_I_D;
        if (r < CV_I_GATE) { p0_item(SrcPlain{in[8] + 4296, in[7], INW, 1.f}, (bf16_t*)(ws + WS_WGATE), 1024, 2048, scr, r, lane); continue; } r -= CV_I_GATE;
        if (r < CV_I_A) { p0_item(SrcPlain{in[10], nullptr, 1024, 1.f}, (bf16_t*)(ws + WS_WAB), 1536, D, scr, r, lane); continue; } r -= CV_I_A;
        if (r < CV_I_SQ) { p0_item(SrcPlain{in[11], in[9], 1024, 1.f}, (bf16_t*)(ws + WS_WAB) + 512, 1536, D, scr, r, lane); continue; } r -= CV_I_SQ;
        if (r < CV_I_SQ) { p0_item(SrcPlain{in[12], nullptr, 1024, 1.f}, (bf16_t*)(ws + WS_WOUT), 1024, D, scr, r, lane); continue; } r -= CV_I_SQ;
        if (r < CV_I_SQ) { p0_item(SrcPlain{in[18], in[17], 1024, 1.f}, (bf16_t*)(ws + WS_WPG), 1024, D, scr, r, lane); continue; } r -= CV_I_SQ;
        p0_item(SrcPlain{in[19], nullptr, 1024, 1.f}, (bf16_t*)(ws + WS_WPP), 256, D, scr, r, lane);
    }
    const float* p = in[1]; bf16_t* pb = (bf16_t*)(ws + WS_PB);
    const int r0 = cv * CV_PROWS, r1 = (r0 + CV_PROWS) < M ? (r0 + CV_PROWS) : M;
    for (int row = r0 + wave; row < r1; row += 8) *(uint2*)(pb + (size_t)row * 256 + lane * 4) = pg8::pack4(*(const f32x4*)(p + (size_t)row * 256 + lane * 4));
}

constexpr int NWAVES = 8, RING_BYTES = 131072, MISC_OFF = RING_BYTES + 320, LDS_BYTES = 147456;
constexpr int CW_PANEL = 8192;
constexpr int CW_Q = 64;
constexpr int CW_BAR = 4096;
struct Args {
    const float* in[21]; float* out; unsigned char* ws; int ph_lo, ph_hi, li, pad;
};
__global__ void __launch_bounds__(NWAVES * 64, 2) mk_fwd(Args args) {
    extern __shared__ __attribute__((aligned(16))) unsigned char lds_raw[];
    LAS unsigned char* lds = (LAS unsigned char*)lds_raw;
    volatile LAS unsigned* MISC = (volatile LAS unsigned*)(lds + MISC_OFF);
    const int wv = __builtin_amdgcn_readfirstlane(threadIdx.x >> 6);
#define TID_NOW() (wv * 64 + lane_now())
    const int G = gridDim.x;
    unsigned char* ws = args.ws;
    for (int u = TID_NOW(); u < (LDS_BYTES - RING_BYTES) / 4; u += NWAVES * 64) ((LAS unsigned*)(lds + RING_BYTES))[u] = 0u;
    __syncthreads();
    XcdBarrier bar = xcd_barrier_post((unsigned*)(ws + WS_CTL) + CW_BAR + args.li * XCD_BAR_WORDS, MISC + 8, TID_NOW());
    const int lo = args.ph_lo, hi = args.ph_hi;
#define IN(k) (lo <= (k) && (k) < hi)
#define BOTH(k) (IN(k) && IN((k) + 1))
#define WSP(T, off) ((T*)(ws + (off)))
    float* H = args.out;
    pg8::UEpi E{}; E.mid_t = -1; E.sc = 1.f; E.rs_tab = (const LAS float*)(lds + RING_BYTES + 1024);
    for (int rep_ = 0; rep_ < (PROBE_REP == 0 ? 2 : 1); ++rep_) if (IN(0)) { const int tid = TID_NOW();
        const int lane = tid & 63, wave = tid >> 6, gw = blockIdx.x * NWAVES + wave, NGW = G * NWAVES;
        LAS float* scr = (LAS float*)(lds + wave * 16384);
        const float* const* in = args.in;
        constexpr int I_GU = (D / 64) * (2 * FF / 32), I_D = (FF / 64) * (D / 32), I_WIN = (D / 64) * (4352 / 32), I_GATE = (D / 64) * (2048 / 32), I_A = (512 / 64) * (D / 32), I_SQ = (D / 64) * (D / 32), I_PP = (256 / 64) * (D / 32);
        constexpr int NITEMS = 2 * I_GU + 2 * I_D + I_WIN + I_GATE + I_A + 3 * I_SQ + I_PP;
        for (int it = gw; it < NITEMS; it += NGW) {
            int r = it;
            if (r < I_GU) { p0_item(SrcGU{in[4], in[5], in[3]}, WSP(bf16_t, WS_WGU1), 1024, 2 * FF, scr, r, lane); continue; } r -= I_GU;
            if (r < I_D) { p0_item(SrcPlain{in[6], nullptr, 1024, 1.f}, WSP(bf16_t, WS_WD1), FF, D, scr, r, lane); continue; } r -= I_D;
            if (r < I_WIN) { p0_item(SrcWin{in[8], in[7]}, WSP(bf16_t, WS_WIN), 1024, 4352, scr, r, lane); continue; } r -= I_WIN;
            if (r < I_GU) { p0_item(SrcGU{in[14], in[15], in[13]}, WSP(bf16_t, WS_WGU2), 1024, 2 * FF, scr, r, lane); continue; } r -= I_GU;
            if (r < I_D) { p0_item(SrcPlain{in[16], nullptr, 1024, 1.f}, WSP(bf16_t, WS_WD2), FF, D, scr, r, lane); continue; } r -= I_D;
            if (r < I_GATE) { p0_item(SrcPlain{in[8] + 4296, in[7], INW, 1.f}, WSP(bf16_t, WS_WGATE), 1024, 2048, scr, r, lane); continue; } r -= I_GATE;
            if (r < I_A) { p0_item(SrcPlain{in[10], nullptr, 1024, 1.f}, WSP(bf16_t, WS_WAB), 1536, D, scr, r, lane); continue; } r -= I_A;
            if (r < I_SQ) { p0_item(SrcPlain{in[11], in[9], 1024, 1.f}, WSP(bf16_t, WS_WAB) + 512, 1536, D, scr, r, lane); continue; } r -= I_SQ;
            if (r < I_SQ) { p0_item(SrcPlain{in[12], nullptr, 1024, 1.f}, WSP(bf16_t, WS_WOUT), 1024, D, scr, r, lane); continue; } r -= I_SQ;
            if (r < I_SQ) { p0_item(SrcPlain{in[18], in[17], 1024, 1.f}, WSP(bf16_t, WS_WPG), 1024, D, scr, r, lane); continue; } r -= I_SQ;
            p0_item(SrcPlain{in[19], nullptr, 1024, 1.f}, WSP(bf16_t, WS_WPP), 256, D, scr, r, lane);
        }
        { const float* p = in[1]; bf16_t* pb = WSP(bf16_t, WS_PB);
          for (size_t i = ((size_t)blockIdx.x * 512 + tid) * 4; i < (size_t)M * 256; i += (size_t)G * 512 * 4) *(uint2*)(pb + i) = pg8::pack4(*(const f32x4*)(p + i)); }
        const float* x = in[0]; bf16_t* hb = WSP(bf16_t, WS_HB); float* ss0 = WSP(float, WS_SS0);
        for (int row = gw; row < M; row += NGW) {
            const f32x4* xr = (const f32x4*)(x + (size_t)row * D) + lane; uint2* o8 = (uint2*)(hb + (size_t)row * D) + lane; float s = 0.f;
#pragma unroll
            for (int j = 0; j < 4; ++j) { const f32x4 v = xr[64 * j]; o8[64 * j] = pg8::pack4(v); s += (v[0] * v[0] + v[1] * v[1]) + (v[2] * v[2] + v[3] * v[3]); }
            s = wave_sum(s);
            if (lane < 16) ss0[(size_t)row * 16 + lane] = lane == 0 ? s : 0.f;
        }
        const int* pos = (const int*)in[2]; float* cs64 = WSP(float, WS_CS64); float* cs32 = WSP(float, WS_CS32);
        __syncthreads();
        LAS float* invt = (LAS float*)lds;
        if (tid < 64) invt[tid] = powf(10000.f, -(float)tid / 64.f);
        __syncthreads();
        for (int i = blockIdx.x * 512 + tid; i < M * 64; i += G * 512) { const int tok = i >> 6, k = i & 63;
            const float ang = (float)pos[tok] * invt[k]; float sn, c; sincosf(ang, &sn, &c);
            cs64[(size_t)tok * 128 + k] = c; cs64[(size_t)tok * 128 + 64 + k] = sn;
            if ((k & 1) == 0) { cs32[(size_t)tok * 64 + (k >> 1)] = c; cs32[(size_t)tok * 64 + 32 + (k >> 1)] = sn; } }
        if (BOTH(0)) xcd_barrier(bar, tid);
    }
    for (int rep_ = 0; rep_ < (PROBE_REP == 1 ? 2 : 1); ++rep_) if (IN(1)) { const int tid = TID_NOW(); pg8::Gemm g{WSP(bf16_t, WS_HB), WSP(bf16_t, WS_WGU1), M, 2 * FF, D}; pg8::StaticOrder S; S.init(M, 2 * FF, G, (int)blockIdx.x);
        pg8::UEpi e = E; e.kind = pg8::EK_GU; e.ss = WSP(float, WS_SS0); e.o = WSP(bf16_t, WS_HID);
        pg8::gemm_phase<false>(lds, g, S, e, tid); if (BOTH(1)) xcd_barrier(bar, tid); }
    for (int rep_ = 0; rep_ < (PROBE_REP == 2 ? 2 : 1); ++rep_) if (IN(2)) { const int tid = TID_NOW(); pg8::Gemm g{WSP(bf16_t, WS_HID), WSP(bf16_t, WS_WD1), M, D, FF}; pg8::StaticOrder S; S.init(M, D, G, (int)blockIdx.x);
        pg8::UEpi e = E; e.kind = pg8::EK_RES; e.res = args.in[0]; e.H = H; e.hb = WSP(bf16_t, WS_HB); e.sc = 0.5f; e.ssout = WSP(float, WS_SS1);
        pg8::gemm_phase<false>(lds, g, S, e, tid); if (BOTH(2)) xcd_barrier(bar, tid); }
    for (int rep_ = 0; rep_ < (PROBE_REP == 3 ? 2 : 1); ++rep_) if (IN(3)) { const int tid = TID_NOW(); pg8::Gemm g{WSP(bf16_t, WS_HB), WSP(bf16_t, WS_WIN), M, 4352, D}; pg8::StaticOrder S; S.init(M, 4352, G, (int)blockIdx.x);
        pg8::UEpi e = E; e.kind = pg8::EK_WIN; e.ss = WSP(float, WS_SS1); e.cs64 = WSP(float, WS_CS64); e.cs32 = WSP(float, WS_CS32);
        e.yb = WSP(bf16_t, WS_YB); e.ak = WSP(bf16_t, WS_AK); e.av = WSP(bf16_t, WS_AV); e.avt = WSP(bf16_t, WS_AVT); e.iq = WSP(bf16_t, WS_IQ); e.ik = WSP(bf16_t, WS_IK);
        e.rq = WSP(bf16_t, WS_RQ); e.rk = WSP(bf16_t, WS_RK); e.rv = WSP(bf16_t, WS_RV); e.iw = WSP(float, WS_IW);
        pg8::gemm_phase<false>(lds, g, S, e, tid); if (BOTH(3)) xcd_barrier(bar, tid); }
    for (int rep_ = 0; rep_ < ((PROBE_REP == 4 || (PROBE_REP >= 41 && PROBE_REP <= 44)) ? 2 : 1); ++rep_) if (IN(4)) { const int tid = TID_NOW();
        const bool st_ = !((PROBE_REP == 4 || (PROBE_REP >= 41 && PROBE_REP <= 44)) && rep_ == 0);
        if (blockIdx.x < 128 && !(PROBE_REP >= 42 && PROBE_REP <= 44 && rep_ == 0)) { const int it_ = (int)blockIdx.x >> 1, pt_ = (int)blockIdx.x & 1;
            ret_item(lds, it_ >> 2, it_ & 3, WSP(bf16_t, WS_RQ), WSP(bf16_t, WS_RK), WSP(bf16_t, WS_RV), WSP(bf16_t, WS_YB), wv, pt_ ? 32 : 16, pt_ ? 16 : 0, st_); }
        __syncthreads();
        for (;;) {
            if (tid == 0) MISC[16] = atomicAdd((unsigned*)(ws + WS_CTL) + CW_Q + 64 * rep_, 1u);
            __syncthreads();
            const unsigned tk = MISC[16];
            __syncthreads();
            if (tk >= 1024u + (unsigned)NCONV) break;
            int du;
            if (tk < 5u * NCONV) { if (tk % 5u == 4u) continue; du = (int)(tk - tk / 5u); } else du = (int)tk - NCONV;
            dsa_unit(lds, du & 15, 63 - (du >> 4), WSP(bf16_t, WS_IQ), WSP(bf16_t, WS_IK), WSP(float, WS_IW), WSP(bf16_t, WS_YB), WSP(bf16_t, WS_AK), WSP(bf16_t, WS_AV), wv, st_);
        }
        if (BOTH(4)) xcd_barrier(bar, tid);
    }
    for (int rep_ = 0; rep_ < (PROBE_REP == 5 ? 2 : 1); ++rep_) if (IN(5)) { const int tid = TID_NOW();
        pg8::StaticOrder S; S.init(M, D, G, (int)blockIdx.x);
        { pg8::Gemm g{WSP(bf16_t, WS_HB), WSP(bf16_t, WS_WGATE), M, D, D};
          pg8::UEpi e = E; e.kind = pg8::EK_GATE; e.ss = WSP(float, WS_SS1); e.o = WSP(bf16_t, WS_GA); pg8::gemm_phase<false>(lds, g, S, e, tid); }
        { pg8::Gemm g{WSP(bf16_t, WS_HB), WSP(bf16_t, WS_WGATE) + (size_t)D * D, M, D, D};
          pg8::UEpi e = E; e.kind = pg8::EK_GATE; e.ss = WSP(float, WS_SS1); e.o = WSP(bf16_t, WS_GB); pg8::gemm_phase<false>(lds, g, S, e, tid); }
        { pg8::Gemm g{WSP(bf16_t, WS_YB), WSP(bf16_t, WS_WAB), M, D, 1536};
          pg8::UEpi e = E; e.kind = pg8::EK_BR; e.mid_t = 8; e.ga = WSP(bf16_t, WS_GA); e.gb = WSP(bf16_t, WS_GB); e.o = WSP(bf16_t, WS_MERGED); pg8::gemm_phase<true>(lds, g, S, e, tid); }
        if (BOTH(5)) xcd_barrier(bar, tid); }
    for (int rep_ = 0; rep_ < (PROBE_REP == 6 ? 2 : 1); ++rep_) if (IN(6)) { const int tid = TID_NOW(); pg8::Gemm g{WSP(bf16_t, WS_MERGED), WSP(bf16_t, WS_WOUT), M, D, D}; pg8::StaticOrder S; S.init(M, D, G, (int)blockIdx.x);
        pg8::UEpi e = E; e.kind = pg8::EK_RES; e.res = H; e.H = H; e.hb = WSP(bf16_t, WS_HB); e.sc = 1.f; e.ssout = WSP(float, WS_SS0);
        pg8::gemm_phase<false>(lds, g, S, e, tid); if (BOTH(6)) xcd_barrier(bar, tid); }
    for (int rep_ = 0; rep_ < (PROBE_REP == 7 ? 2 : 1); ++rep_) if (IN(7)) { const int tid = TID_NOW(); pg8::Gemm g{WSP(bf16_t, WS_HB), WSP(bf16_t, WS_WGU2), M, 2 * FF, D}; pg8::StaticOrder S; S.init(M, 2 * FF, G, (int)blockIdx.x);
        pg8::UEpi e = E; e.kind = pg8::EK_GU; e.ss = WSP(float, WS_SS0); e.o = WSP(bf16_t, WS_HID);
        pg8::gemm_phase<false>(lds, g, S, e, tid); if (BOTH(7)) xcd_barrier(bar, tid); }
    for (int rep_ = 0; rep_ < (PROBE_REP == 8 ? 2 : 1); ++rep_) if (IN(8)) { const int tid = TID_NOW(); pg8::Gemm g{WSP(bf16_t, WS_HID), WSP(bf16_t, WS_WD2), M, D, FF}; pg8::StaticOrder S; S.init(M, D, G, (int)blockIdx.x);
        pg8::UEpi e = E; e.kind = pg8::EK_RES; e.res = H; e.H = H; e.hb = WSP(bf16_t, WS_HB); e.sc = 0.5f; e.ssout = WSP(float, WS_SS1);
        pg8::gemm_phase<false>(lds, g, S, e, tid); if (BOTH(8)) xcd_barrier(bar, tid); }
    for (int rep_ = 0; rep_ < (PROBE_REP == 9 ? 2 : 1); ++rep_) if (IN(9)) { const int tid = TID_NOW();
        pg8::StaticOrder S; S.init(M, D, G, (int)blockIdx.x);
        { pg8::Gemm g{WSP(bf16_t, WS_PB), WSP(bf16_t, WS_WPP), M, D, 256};
          pg8::UEpi e = E; e.kind = pg8::EK_PP; e.pp = WSP(float, WS_PP); pg8::gemm_phase<false>(lds, g, S, e, tid); }
        { pg8::Gemm g{WSP(bf16_t, WS_HB), WSP(bf16_t, WS_WPG), M, D, D};
          pg8::UEpi e = E; e.kind = pg8::EK_PLE; e.ss = WSP(float, WS_SS1); e.pp = WSP(float, WS_PP); e.H = H; e.ssout = WSP(float, WS_SS0); pg8::gemm_phase<false>(lds, g, S, e, tid); }
        { pg8::Unit u; unsigned* pcnt = (unsigned*)(ws + WS_CTL) + CW_PANEL; const float* gf = args.in[20]; const float* ss = WSP(float, WS_SS0);
          __syncthreads();
          if (tid == 0) { __builtin_amdgcn_fence(__ATOMIC_RELEASE, "agent"); asm volatile("s_waitcnt vmcnt(0)" ::: "memory");
              for (int i = 0; S.next(i, u); ++i) (void)__hip_atomic_fetch_add(pcnt + u.pm, 1u, __ATOMIC_RELAXED, __HIP_MEMORY_SCOPE_AGENT); }
          for (int i = 0; S.next(i, u); ++i) {
              if (tid == 0) { unsigned sp = 0u;
                  while (__hip_atomic_load(pcnt + u.pm, __ATOMIC_RELAXED, __HIP_MEMORY_SCOPE_AGENT) < 4u) { __builtin_amdgcn_s_sleep(2); if (++sp > (1u << 22)) break; }
                  __builtin_amdgcn_fence(__ATOMIC_ACQUIRE, "agent"); asm volatile("s_waitcnt vmcnt(0)" ::: "memory"); }
              __syncthreads();
              const int lane = tid & 63; const f32x4 gg = *((const f32x4*)(gf + u.pn * 256) + lane);
              for (int row = u.pm * 256 + (tid >> 6); row < u.pm * 256 + 256; row += NWAVES) { const float rs = row_rstd(ss, row);
                  f32x4* p = (f32x4*)(H + (size_t)row * D + u.pn * 256) + lane; *p = *p * gg * rs; }
              __syncthreads();
          } }
    }
#undef IN
#undef BOTH
#undef WSP
}

extern "C" void kernel_launch(void* const* d_in, const int* in_sizes, int n_in, void* d_out, int out_size, void* d_ws, size_t ws_size, hipStream_t stream) {
    if (n_in != 21 || out_size != M * D || ws_size < WS_END) { fprintf(stderr, "kernel_launch: unexpected shapes (n_in %d out %d ws %zu)\n", n_in, out_size, ws_size); return; }
    static int grid = 0;
    if (grid == 0) {
        int dev = 0, cus = 0;
        if (hipGetDevice(&dev) != hipSuccess || hipDeviceGetAttribute(&cus, hipDeviceAttributeMultiprocessorCount, dev) != hipSuccess) { grid = -1; return; }
        if (hipFuncSetAttribute((const void*)mk_fwd, hipFuncAttributeMaxDynamicSharedMemorySize, LDS_BYTES) != hipSuccess) { fprintf(stderr, "hipFuncSetAttribute failed\n"); grid = -1; return; }
        grid = cus;
    }
    if (grid < 0) return;
    const float* x = (const float*)d_in[0]; const float* p = (const float*)d_in[1]; const int* pos = (const int*)d_in[2];
    const float* g1 = (const float*)d_in[3]; const float* wg1 = (const float*)d_in[4]; const float* wu1 = (const float*)d_in[5]; const float* wd1 = (const float*)d_in[6];
    const float* gmix = (const float*)d_in[7]; const float* win = (const float*)d_in[8]; const float* retgn = (const float*)d_in[9];
    const float* wba = (const float*)d_in[10]; const float* wbb = (const float*)d_in[11]; const float* wout = (const float*)d_in[12];
    const float* g2 = (const float*)d_in[13]; const float* wg2 = (const float*)d_in[14]; const float* wu2 = (const float*)d_in[15]; const float* wd2 = (const float*)d_in[16];
    const float* gple = (const float*)d_in[17]; const float* wpg = (const float*)d_in[18]; const float* wpp = (const float*)d_in[19];
    unsigned char* ws = (unsigned char*)d_ws;
#define WSP(T, off) ((T*)(ws + (off)))
    bf16_t *WGU1 = WSP(bf16_t, WS_WGU1), *WD1 = WSP(bf16_t, WS_WD1), *WIN = WSP(bf16_t, WS_WIN), *WGATE = WSP(bf16_t, WS_WGATE), *WAB = WSP(bf16_t, WS_WAB), *WOUT = WSP(bf16_t, WS_WOUT);
    bf16_t *WGU2 = WSP(bf16_t, WS_WGU2), *WD2 = WSP(bf16_t, WS_WD2), *WPG = WSP(bf16_t, WS_WPG), *WPP = WSP(bf16_t, WS_WPP);
    float *CS64 = WSP(float, WS_CS64), *CS32 = WSP(float, WS_CS32), *SS0 = WSP(float, WS_SS0);
    bf16_t *HB = WSP(bf16_t, WS_HB), *PB = WSP(bf16_t, WS_PB), *IQ = WSP(bf16_t, WS_IQ), *RQ = WSP(bf16_t, WS_RQ), *RK = WSP(bf16_t, WS_RK);
    bf16_t *AK = WSP(bf16_t, WS_AK), *AV = WSP(bf16_t, WS_AV), *IK = WSP(bf16_t, WS_IK);
    bf16_t *YB = WSP(bf16_t, WS_YB), *RV = WSP(bf16_t, WS_RV);
    float *IW = WSP(float, WS_IW); unsigned* MASK = WSP(unsigned, WS_MASK);
    if (hipMemsetAsync(ws + WS_CTL, 0, 256 * 1024, stream) != hipSuccess) { fprintf(stderr, "memset failed\n"); return; }
    Args a{};
    for (int i = 0; i < 21; ++i) a.in[i] = (const float*)d_in[i];
    a.out = (float*)d_out; a.ws = ws;
    a.ph_lo = 0; a.ph_hi = 10; a.li = 0;
    hipLaunchKernelGGL(mk_fwd, dim3(grid), dim3(NWAVES * 64), LDS_BYTES, stream, a);
#undef WSP
}
```

```cpp
#include <hip/hip_runtime.h>
#include <cstdint>
#include <cstdio>

typedef unsigned short bf16_t;
typedef short bf16x8 __attribute__((ext_vector_type(8)));
typedef float f32x4 __attribute__((ext_vector_type(4)));
typedef float f32x16 __attribute__((ext_vector_type(16)));
typedef unsigned u32x4 __attribute__((ext_vector_type(4)));
typedef unsigned u32x2 __attribute__((ext_vector_type(2)));

#ifndef PROBE_REP
#define PROBE_REP -1
#endif
constexpr int M = 32768, D = 1024, FF = 2816, SEQ = 2048, NBATCH = 16, INW = 6344;
constexpr float EPS = 1e-6f, GN_EPS = 1e-5f;

constexpr size_t MiB = 1u << 20;
constexpr size_t WS_CTL = 0;
constexpr size_t WS_WGU1 = 1 * MiB;
constexpr size_t WS_WD1 = WS_WGU1 + 11 * MiB;
constexpr size_t WS_WIN = WS_WD1 + 11 * MiB / 2;
constexpr size_t WS_WGATE = WS_WIN + 17 * MiB / 2;
constexpr size_t WS_WAB = WS_WGATE + 4 * MiB;
constexpr size_t WS_WOUT = WS_WAB + 3 * MiB;
constexpr size_t WS_WGU2 = WS_WOUT + 2 * MiB;
constexpr size_t WS_WD2 = WS_WGU2 + 11 * MiB;
constexpr size_t WS_WPG = WS_WD2 + 11 * MiB / 2;
constexpr size_t WS_WPP = WS_WPG + 2 * MiB;
constexpr size_t WS_CS64 = 56 * MiB;
constexpr size_t WS_CS32 = 72 * MiB;
constexpr size_t WS_SS0 = 80 * MiB;
constexpr size_t WS_SS1 = 82 * MiB;
constexpr size_t WS_HB = 84 * MiB;
constexpr size_t WS_PB = 148 * MiB;
constexpr size_t WS_R1 = 164 * MiB;
constexpr size_t WS_HID = WS_R1;
constexpr size_t WS_IQ = WS_R1;
constexpr size_t WS_RQ = WS_R1 + 32 * MiB;
constexpr size_t WS_RK = WS_R1 + 64 * MiB;
constexpr size_t WS_AK = WS_R1 + 96 * MiB;
constexpr size_t WS_AV = WS_R1 + 100 * MiB;
constexpr size_t WS_IK = WS_R1 + 104 * MiB;
constexpr size_t WS_IW = WS_R1 + 108 * MiB;
constexpr size_t WS_MASK = WS_R1 + 109 * MiB;
constexpr size_t WS_AVT = WS_R1 + 117 * MiB;
constexpr size_t WS_GA = WS_R1;
constexpr size_t WS_MERGED = WS_R1 + 64 * MiB;
constexpr size_t WS_PP = WS_R1;
constexpr size_t WS_H4B = WS_R1 + 64 * MiB;
constexpr size_t WS_R2 = 340 * MiB;
constexpr size_t WS_YB = WS_R2;
constexpr size_t WS_RV = WS_R2 + 96 * MiB;
constexpr size_t WS_GB = WS_RV;
constexpr size_t WS_END = 500 * MiB;
static_assert(WS_WPP + MiB / 2 <= WS_CS64 && WS_MASK + 8 * MiB <= WS_R1 + 176 * MiB && WS_R1 + 176 * MiB == WS_R2 && WS_RV + 64 * MiB == WS_END, "ws map");

__device__ __forceinline__ float bf2f(bf16_t b) { return __uint_as_float(((unsigned)b) << 16); }
__device__ __forceinline__ bf16_t f2bf(float f) { unsigned u = __float_as_uint(f); return (bf16_t)((u + 0x7fffu + ((u >> 16) & 1u)) >> 16); }
__device__ __forceinline__ float silu_f(float x) { return x / (1.f + __expf(-x)); }
__device__ __forceinline__ float sigm_f(float x) { return 1.f / (1.f + __expf(-x)); }
__device__ __forceinline__ float wave_sum(float v) {
#pragma unroll
    for (int o = 1; o < 64; o <<= 1) v += __shfl_xor(v, o);
    return v;
}
__device__ __forceinline__ float wave_max(float v) {
#pragma unroll
    for (int o = 1; o < 64; o <<= 1) v = fmaxf(v, __shfl_xor(v, o));
    return v;
}

__host__ __device__ __forceinline__ int win_src(int t, int c, float& sc) {
    sc = 1.f;
    const int hi = c >> 7, cc = c & 127;
    if (t < 2) { sc = 0.125f * 1.4426950408889634f; const int head = 4 * t + (cc >> 5), d = cc & 31; return head * 64 + hi * 32 + d; }
    if (t == 2) {
        if (!hi) { if (cc < 32) return 512 + cc; if (cc < 64) return 1152 + (cc - 32); if (cc < 96) return 576 + (cc - 64); return 576 + 32 + (cc - 96); }
        if (cc < 32) return 512 + 32 + cc; if (cc < 64) return 1152 + 32 + (cc - 32); if (cc < 72) { sc = 0.35355339059327373f; return 1216 + (cc - 64); } return -1;
    }
    if (t < 5) { sc = 0.125f; const int head = 4 * (t - 3) + (cc >> 5), d = cc & 31; return 640 + head * 64 + hi * 32 + d; }
    if (t < 7) { const int head = 2 * (t - 5) + (cc >> 6), d = cc & 63; return 1224 + head * 128 + hi * 64 + d; }
    if (t < 9) { sc = 0.08838834764831845f; const int head = 2 * (t - 7) + (cc >> 6), d = cc & 63; return 1736 + head * 128 + hi * 64 + d; }
    if (t < 13) return 2248 + 256 * (t - 9) + c;
    return 3272 + 256 * (t - 13) + c;
}

struct SrcPlain { const float* W; const float* gk; int ldw; float scale;
    __device__ float operator()(int n, int k) const { float v = W[(size_t)k * ldw + n]; if (gk) v *= gk[k]; return v * scale; }
    __device__ f32x4 f4(int n, int k) const { const f32x4 v = *(const f32x4*)(W + (size_t)k * ldw + n); return v * ((gk ? gk[k] : 1.f) * scale); } };
struct SrcGU { const float* Wg; const float* Wu; const float* gk;
    __device__ float operator()(int n, int k) const { const int t = n >> 8, c = n & 255; const long delta = (const char*)Wu - (const char*)Wg; const float* W = (const float*)((const char*)Wg + (c < 128 ? 0l : delta)); return W[(size_t)k * FF + t * 128 + (c & 127)] * gk[k]; }
    __device__ f32x4 f4(int n, int k) const { const int t = n >> 8, c = n & 255; const long delta = (const char*)Wu - (const char*)Wg; const float* W = (const float*)((const char*)Wg + (c < 128 ? 0l : delta)); return *(const f32x4*)(W + (size_t)k * FF + t * 128 + (c & 127)) * gk[k]; } };
struct SrcWin { const float* W; const float* gk;
    __device__ float operator()(int n, int k) const { float sc; const int col = win_src(n >> 8, n & 255, sc); if (col < 0) return 0.f; return W[(size_t)k * INW + col] * gk[k] * sc; }
    __device__ f32x4 f4(int n, int k) const { float sc; const int col = win_src(n >> 8, n & 255, sc); if (col < 0) return (f32x4){0.f, 0.f, 0.f, 0.f}; return *(const f32x4*)(W + (size_t)k * INW + col) * (gk[k] * sc); } };

template <class F> __global__ void __launch_bounds__(256) prep_wt(F f, bf16_t* out, int ldo) {
    __shared__ float tile[32][33];
    const int n0 = blockIdx.x * 32, k0 = blockIdx.y * 32, tx = threadIdx.x, ty = threadIdx.y;
    for (int i = ty; i < 32; i += 8) tile[i][tx] = f(n0 + tx, k0 + i);
    __syncthreads();
    for (int i = ty; i < 32; i += 8) out[(size_t)(n0 + i) * ldo + k0 + tx] = f2bf(tile[tx][i]);
}

__global__ void __launch_bounds__(256) prep_x(const float* x, bf16_t* hb, float* ss) {
    __shared__ float red[4];
    const int row = blockIdx.x, tid = threadIdx.x;
    const f32x4 v = *(const f32x4*)(x + (size_t)row * D + tid * 4);
    uint2 o; o.x = (unsigned)f2bf(v.x) | ((unsigned)f2bf(v.y) << 16); o.y = (unsigned)f2bf(v.z) | ((unsigned)f2bf(v.w) << 16);
    *(uint2*)(hb + (size_t)row * D + tid * 4) = o;
    float s = wave_sum(v.x * v.x + v.y * v.y + v.z * v.z + v.w * v.w);
    if ((tid & 63) == 0) red[tid >> 6] = s;
    __syncthreads();
    if (tid < 16) ss[(size_t)row * 16 + tid] = tid == 0 ? (red[0] + red[1]) + (red[2] + red[3]) : 0.f;
}
__global__ void __launch_bounds__(256) k_rowss(const float* h, float* ss) {
    __shared__ float red[4];
    const int row = blockIdx.x, tid = threadIdx.x;
    const f32x4 v = *(const f32x4*)(h + (size_t)row * D + tid * 4);
    float s = wave_sum(v.x * v.x + v.y * v.y + v.z * v.z + v.w * v.w);
    if ((tid & 63) == 0) red[tid >> 6] = s;
    __syncthreads();
    if (tid < 16) ss[(size_t)row * 16 + tid] = tid == 0 ? (red[0] + red[1]) + (red[2] + red[3]) : 0.f;
}
__global__ void __launch_bounds__(256) prep_p(const float* p, bf16_t* pb) {
    const size_t i = ((size_t)blockIdx.x * 256 + threadIdx.x) * 4;
    const f32x4 v = *(const f32x4*)(p + i);
    uint2 o; o.x = (unsigned)f2bf(v.x) | ((unsigned)f2bf(v.y) << 16); o.y = (unsigned)f2bf(v.z) | ((unsigned)f2bf(v.w) << 16);
    *(uint2*)(pb + i) = o;
}
__global__ void __launch_bounds__(256) prep_rope(const int* pos, float* cs64, float* cs32) {
    const int i = blockIdx.x * 256 + threadIdx.x, tok = i >> 6, k = i & 63;
    const float inv = powf(10000.f, -(float)k / 64.f);
    const float ang = (float)pos[tok] * inv;
    const float c = cosf(ang), s = sinf(ang);
    cs64[(size_t)tok * 128 + k] = c; cs64[(size_t)tok * 128 + 64 + k] = s;
    if ((k & 1) == 0) { cs32[(size_t)tok * 64 + (k >> 1)] = c; cs32[(size_t)tok * 64 + 32 + (k >> 1)] = s; }
}

__device__ __forceinline__ float row_rstd(const float* ss, int row) {
    const f32x4* p = (const f32x4*)(ss + (size_t)row * 16);
    const f32x4 a = p[0], b = p[1], c = p[2], d = p[3];
    const float s = ((a.x + a.y) + (a.z + a.w)) + ((b.x + b.y) + (b.z + b.w)) + ((c.x + c.y) + (c.z + c.w)) + ((d.x + d.y) + (d.z + d.w));
    return rsqrtf(s * (1.f / 1024.f) + EPS);
}
struct EGU {
    static constexpr bool HAS_MID = false; static constexpr int MIDK = 0;
    const float* ss; bf16_t* hid;
    __device__ float rowscale(int row) const { return row_rstd(ss, row); }
    __device__ void elem(int row, int t, int c, float v0, float v1, float rs) const { hid[(size_t)row * FF + t * 128 + c] = f2bf(silu_f(v0 * rs) * (v1 * rs)); }
    __device__ void mid(int, int, int, float&, float&) const {}
};
struct ERES {
    static constexpr bool HAS_MID = false; static constexpr int MIDK = 0;
    const float* res; float* H; bf16_t* hb; float sc;
    __device__ float rowscale(int) const { return 1.f; }
    __device__ void elem(int row, int t, int c, float v0, float v1, float) const {
        const size_t i0 = (size_t)row * D + t * 256 + c, i1 = i0 + 128;
        const float h0 = res[i0] + sc * v0, h1 = res[i1] + sc * v1;
        H[i0] = h0; H[i1] = h1; hb[i0] = f2bf(h0); hb[i1] = f2bf(h1);
    }
    __device__ void mid(int, int, int, float&, float&) const {}
};
struct EWIN {
    static constexpr bool HAS_MID = false; static constexpr int MIDK = 0;
    const float* ss; const float* cs64; const float* cs32;
    bf16_t *yb, *ak, *av, *iq, *ik, *rq, *rk, *rv; float* iw;
    __device__ float rowscale(int row) const { return row_rstd(ss, row); }
    __device__ void elem(int row, int t, int c, float v0, float v1, float rs) const {
        const float a = v0 * rs, b = v1 * rs;
        if (t < 2 || t == 3 || t == 4) {
            const int tt = t < 2 ? t : t - 3, head = 4 * tt + (c >> 5), d = c & 31;
            const float cs = cs32[(size_t)row * 64 + d], sn = cs32[(size_t)row * 64 + 32 + d];
            const float o1 = a * cs - b * sn, o2 = b * cs + a * sn;
            if (t < 2) { bf16_t* o = yb + (size_t)row * 1536 + head * 64 + d; o[0] = f2bf(o1); o[32] = f2bf(o2); }
            else { bf16_t* o = iq + (size_t)row * 512 + head * 64 + d; o[0] = f2bf(o1); o[32] = f2bf(o2); }
        } else if (t == 2) {
            if (c < 64) {
                const int d = c & 31;
                const float cs = cs32[(size_t)row * 64 + d], sn = cs32[(size_t)row * 64 + 32 + d];
                const float o1 = a * cs - b * sn, o2 = b * cs + a * sn;
                bf16_t* o = (c < 32 ? ak : ik) + (size_t)row * 64 + d; o[0] = f2bf(o1); o[32] = f2bf(o2);
            } else {
                av[(size_t)row * 64 + (c - 64)] = f2bf(a);
                if (c < 72) iw[(size_t)row * 8 + (c - 64)] = b;
            }
        } else if (t < 9) {
            const int tt = t < 7 ? t - 5 : t - 7, head = 2 * tt + (c >> 6), d = c & 63;
            const float cs = cs64[(size_t)row * 128 + d], sn = cs64[(size_t)row * 128 + 64 + d];
            const float o1 = a * cs - b * sn, o2 = b * cs + a * sn;
            bf16_t* o = (t < 7 ? rq : rk) + (size_t)row * 512 + head * 128 + d; o[0] = f2bf(o1); o[64] = f2bf(o2);
        } else if (t < 13) {
            bf16_t* o = rv + (size_t)row * 1024 + 256 * (t - 9) + c; o[0] = f2bf(a); o[128] = f2bf(b);
        } else {
            bf16_t* o = yb + (size_t)row * 1536 + 512 + 256 * (t - 13) + c; o[0] = f2bf(silu_f(a)); o[128] = f2bf(silu_f(b));
        }
    }
    __device__ void mid(int, int, int, float&, float&) const {}
};
struct EGATE {
    static constexpr bool HAS_MID = false; static constexpr int MIDK = 0;
    const float* ss; bf16_t *ga, *gb;
    __device__ float rowscale(int row) const { return row_rstd(ss, row); }
    __device__ void elem(int row, int t, int c, float v0, float v1, float rs) const {
        bf16_t* o = (t < 4 ? ga : gb) + (size_t)row * D + 256 * (t & 3) + c; o[0] = f2bf(sigm_f(v0 * rs)); o[128] = f2bf(sigm_f(v1 * rs));
    }
    __device__ void mid(int, int, int, float&, float&) const {}
};
struct EBR {
    static constexpr bool HAS_MID = true; static constexpr int MIDK = 512;
    const bf16_t *ga, *gb; bf16_t* merged;
    __device__ float rowscale(int) const { return 1.f; }
    __device__ void mid(int row, int t, int c, float& v0, float& v1) const {
        const size_t i0 = (size_t)row * D + 256 * t + c, i1 = i0 + 128;
        v0 *= bf2f(ga[i0]) / bf2f(gb[i0]); v1 *= bf2f(ga[i1]) / bf2f(gb[i1]);
    }
    __device__ void elem(int row, int t, int c, float v0, float v1, float) const {
        const size_t i0 = (size_t)row * D + 256 * t + c, i1 = i0 + 128;
        merged[i0] = f2bf(v0 * bf2f(gb[i0])); merged[i1] = f2bf(v1 * bf2f(gb[i1]));
    }
};
struct EPP {
    static constexpr bool HAS_MID = false; static constexpr int MIDK = 0;
    float* pp;
    __device__ float rowscale(int) const { return 1.f; }
    __device__ void elem(int row, int t, int c, float v0, float v1, float) const { const size_t i0 = (size_t)row * D + 256 * t + c; pp[i0] = v0; pp[i0 + 128] = v1; }
    __device__ void mid(int, int, int, float&, float&) const {}
};
struct EPLE {
    static constexpr bool HAS_MID = false; static constexpr int MIDK = 0;
    const float* ss; const float* pp; float* H;
    __device__ float rowscale(int row) const { return row_rstd(ss, row); }
    __device__ void elem(int row, int t, int c, float v0, float v1, float rs) const {
        const size_t i0 = (size_t)row * D + 256 * t + c, i1 = i0 + 128;
        H[i0] = H[i0] + sigm_f(v0 * rs) * pp[i0]; H[i1] = H[i1] + sigm_f(v1 * rs) * pp[i1];
    }
    __device__ void mid(int, int, int, float&, float&) const {}
};

template <class Epi> __global__ void __launch_bounds__(256) ngemm(const bf16_t* A, int lda, const bf16_t* Bt, int ldb, int K, Epi E) {
    const int wid = threadIdx.x >> 6, lane = threadIdx.x & 63, r = lane & 31, h = lane >> 5;
    const int row0 = blockIdx.x * 32, t = blockIdx.y;
    const bf16_t* ap = A + (size_t)(row0 + r) * lda + 8 * h;
    const bf16_t* b0 = Bt + (size_t)(t * 256 + wid * 32 + r) * ldb + 8 * h;
    const bf16_t* b1 = b0 + (size_t)128 * ldb;
    f32x16 c0, c1;
#pragma unroll
    for (int i = 0; i < 16; ++i) { c0[i] = 0.f; c1[i] = 0.f; }
    for (int k = 0; k < K; k += 16) {
        if (Epi::HAS_MID && k == Epi::MIDK) {
#pragma unroll
            for (int reg = 0; reg < 16; ++reg) { const int row = row0 + (reg & 3) + 8 * (reg >> 2) + 4 * h; float v0 = c0[reg], v1 = c1[reg]; E.mid(row, t, wid * 32 + r, v0, v1); c0[reg] = v0; c1[reg] = v1; }
        }
        const bf16x8 a = *(const bf16x8*)(ap + k), x0 = *(const bf16x8*)(b0 + k), x1 = *(const bf16x8*)(b1 + k);
        c0 = __builtin_amdgcn_mfma_f32_32x32x16_bf16(a, x0, c0, 0, 0, 0);
        c1 = __builtin_amdgcn_mfma_f32_32x32x16_bf16(a, x1, c1, 0, 0, 0);
    }
#pragma unroll
    for (int reg = 0; reg < 16; ++reg) {
        const int row = row0 + (reg & 3) + 8 * (reg >> 2) + 4 * h;
        const float rs = E.rowscale(row);
        E.elem(row, t, wid * 32 + r, c0[reg], c1[reg], rs);
    }
}

__device__ __forceinline__ void ld_row64(const bf16_t* p, float (&k)[64]) {
#pragma unroll
    for (int i = 0; i < 8; ++i) { const u32x4 w = *(const u32x4*)(p + 8 * i);
        k[8 * i + 0] = __uint_as_float(w.x << 16); k[8 * i + 1] = __uint_as_float(w.x & 0xffff0000u);
        k[8 * i + 2] = __uint_as_float(w.y << 16); k[8 * i + 3] = __uint_as_float(w.y & 0xffff0000u);
        k[8 * i + 4] = __uint_as_float(w.z << 16); k[8 * i + 5] = __uint_as_float(w.z & 0xffff0000u);
        k[8 * i + 6] = __uint_as_float(w.w << 16); k[8 * i + 7] = __uint_as_float(w.w & 0xffff0000u); }
}
__device__ __forceinline__ int block_sum_i(int v, int* red) {
    int s = v;
#pragma unroll
    for (int o = 1; o < 64; o <<= 1) s += __shfl_xor(s, o);
    __syncthreads();
    if ((threadIdx.x & 63) == 0) red[threadIdx.x >> 6] = s;
    __syncthreads();
    return (red[0] + red[1]) + (red[2] + red[3]);
}
__device__ __forceinline__ float block_sum_f(float v, float* red) {
    const float s = wave_sum(v);
    __syncthreads();
    if ((threadIdx.x & 63) == 0) red[threadIdx.x >> 6] = s;
    __syncthreads();
    return (red[0] + red[1]) + (red[2] + red[3]);
}

__global__ void __launch_bounds__(256) k_index_select(const bf16_t* IQ, const bf16_t* IK, const float* IW, unsigned* MASK) {
    __shared__ float q[512]; __shared__ float w[8]; __shared__ unsigned key[2048]; __shared__ unsigned msk[64]; __shared__ int red[4];
    const int tok = blockIdx.x, b = tok >> 11, s = tok & 2047, L = ((s >> 6) + 1) << 6, tid = threadIdx.x;
    for (int i = tid; i < 512; i += 256) q[i] = bf2f(IQ[(size_t)tok * 512 + i]);
    if (tid < 8) w[tid] = IW[(size_t)tok * 8 + tid];
    if (tid < 64) msk[tid] = 0u;
    __syncthreads();
    for (int j = tid; j < L; j += 256) {
        float k[64]; ld_row64(IK + (size_t)(b * SEQ + j) * 64, k);
        float sc = 0.f;
#pragma unroll
        for (int hh = 0; hh < 8; ++hh) { float d = 0.f;
#pragma unroll
            for (int i = 0; i < 64; ++i) d += q[hh * 64 + i] * k[i];
            sc += w[hh] * fmaxf(d, 0.f); }
        sc += 0.f;
        unsigned u = __float_as_uint(sc); u ^= (u >> 31) ? 0xffffffffu : 0x80000000u;
        key[j] = u;
    }
    __syncthreads();
    if (L <= 256) { for (int j = tid; j < L; j += 256) atomicOr(&msk[j >> 5], 1u << (j & 31)); }
    else {
        unsigned T = 0u;
        for (int bit = 31; bit >= 0; --bit) {
            const unsigned cand = T | (1u << bit); int c = 0;
            for (int j = tid; j < L; j += 256) c += key[j] >= cand ? 1 : 0;
            if (block_sum_i(c, red) >= 256) T = cand;
        }
        int c = 0;
        for (int j = tid; j < L; j += 256) { if (key[j] > T) { c++; atomicOr(&msk[j >> 5], 1u << (j & 31)); } }
        int need = 256 - block_sum_i(c, red);
        if (tid == 0) { for (int j = 0; j < L && need > 0; ++j) if (key[j] == T) { msk[j >> 5] |= 1u << (j & 31); --need; } }
    }
    __syncthreads();
    if (tid < 64) MASK[(size_t)tok * 64 + tid] = msk[tid];
}

__global__ void __launch_bounds__(256) k_attn_naive(bf16_t* YB, const bf16_t* AK, const bf16_t* AV, const unsigned* MASK) {
    __shared__ float q[512]; __shared__ unsigned msk[64]; __shared__ float lg[4][2048]; __shared__ float rinv[4];
    const int tok = blockIdx.x, b = tok >> 11, s = tok & 2047, L = ((s >> 6) + 1) << 6, tid = threadIdx.x, wid = tid >> 6, lane = tid & 63;
    for (int i = tid; i < 512; i += 256) q[i] = bf2f(YB[(size_t)tok * 1536 + i]);
    if (tid < 64) msk[tid] = MASK[(size_t)tok * 64 + tid];
    __syncthreads();
    for (int hg = 0; hg < 2; ++hg) {
        for (int j = tid; j < L; j += 256) {
            if ((msk[j >> 5] >> (j & 31)) & 1u) {
                float k[64]; ld_row64(AK + (size_t)(b * SEQ + j) * 64, k);
#pragma unroll
                for (int hh = 0; hh < 4; ++hh) { float d = 0.f;
#pragma unroll
                    for (int i = 0; i < 64; ++i) d += q[(hg * 4 + hh) * 64 + i] * k[i];
                    lg[hh][j] = d; }
            } else {
#pragma unroll
                for (int hh = 0; hh < 4; ++hh) lg[hh][j] = -1e30f;
            }
        }
        __syncthreads();
        {
            float m = -1e30f;
            for (int j = lane; j < L; j += 64) m = fmaxf(m, lg[wid][j]);
            m = wave_max(m);
            float sum = 0.f;
            for (int j = lane; j < L; j += 64) { const float x = lg[wid][j]; const float p = x > -5e29f ? __expf(x - m) : 0.f; lg[wid][j] = p; sum += p; }
            sum = wave_sum(sum);
            if (lane == 0) rinv[wid] = 1.f / sum;
        }
        __syncthreads();
        {
            float o = 0.f;
            for (int j = 0; j < L; ++j) { const float p = lg[wid][j]; if (p != 0.f) o += p * bf2f(AV[(size_t)(b * SEQ + j) * 64 + lane]); }
            YB[(size_t)tok * 1536 + (hg * 4 + wid) * 64 + lane] = f2bf(o * rinv[wid]);
        }
        __syncthreads();
    }
}

__global__ void __launch_bounds__(256) k_ret_naive(const bf16_t* RQ, const bf16_t* RK, const bf16_t* RV, bf16_t* YB) {
    __shared__ float q[128]; __shared__ float sc[256]; __shared__ float red[4];
    const int tok = blockIdx.x, h = blockIdx.y, b = tok >> 11, s = tok & 2047, L = ((s >> 6) + 1) << 6, tid = threadIdx.x;
    if (tid < 128) q[tid] = bf2f(RQ[(size_t)tok * 512 + h * 128 + tid]);
    __syncthreads();
    const float lg2 = log2f(1.f - exp2f(-5.f - (float)h));
    float y = 0.f;
    for (int j0 = 0; j0 < L; j0 += 256) {
        const int j = j0 + tid; float sv = 0.f;
        if (j < L) {
            const bf16_t* kr = RK + (size_t)(b * SEQ + j) * 512 + h * 128; float d = 0.f;
#pragma unroll
            for (int hf = 0; hf < 2; ++hf) { float k[64]; ld_row64(kr + 64 * hf, k);
#pragma unroll
                for (int i = 0; i < 64; ++i) d += q[hf * 64 + i] * k[i]; }
            const int dist = s > j ? s - j : j - s;
            sv = d * exp2f(lg2 * (float)dist);
        }
        sc[tid] = sv;
        __syncthreads();
        const int n = (L - j0) < 256 ? (L - j0) : 256;
        for (int jj = 0; jj < n; ++jj) y += sc[jj] * bf2f(RV[(size_t)(b * SEQ + j0 + jj) * 1024 + h * 256 + tid]);
        __syncthreads();
    }
    const float mean = block_sum_f(y, red) * (1.f / 256.f);
    const float dv = y - mean;
    const float var = block_sum_f(dv * dv, red) * (1.f / 256.f);
    const float yn = dv * rsqrtf(var + GN_EPS);
    bf16_t* o = YB + (size_t)tok * 1536 + 512 + h * 256 + tid;
    *o = f2bf(yn * bf2f(*o));
}

__global__ void __launch_bounds__(256) k_final(float* h, const float* ss, const float* g) {
    const int row = blockIdx.x, tid = threadIdx.x;
    const float rs = row_rstd(ss, row);
    f32x4 v = *(const f32x4*)(h + (size_t)row * D + tid * 4); const f32x4 gg = *(const f32x4*)(g + tid * 4);
    v.x *= rs * gg.x; v.y *= rs * gg.y; v.z *= rs * gg.z; v.w *= rs * gg.w;
    *(f32x4*)(h + (size_t)row * D + tid * 4) = v;
}


namespace pg8 {
#define PG8_LAS __attribute__((address_space(3)))
constexpr int BM = 256, BK = 64, HALF = 128, HTB = HALF * BK * 2, STAGE_BYTES = 8 * HTB, NXCD = 8, WGM = 4;
__host__ __device__ __forceinline__ int lds_byte(int r, int c) { const int st = (r >> 4) * 2 + (c >> 5), rr = r & 15, cc = c & 31, ob = rr * 64 + cc * 2; return st * 1024 + (ob ^ (((ob >> 9) & 1) << 5)); }
__host__ __device__ __forceinline__ void stage_rc(int b, int& R, int& C) { const int st = b / 1024, sb = b % 1024, swz = sb ^ (((sb >> 9) & 1) << 5); R = (st >> 1) * 16 + swz / 64; C = (st & 1) * 32 + (swz % 64) / 2; }
struct Unit { int pm, pn; };
struct Gemm { const bf16_t* A; const bf16_t* Bt; int M, N, K; };
struct StaticOrder {
    int nM, nN, nwg, G, c;
    __device__ void init(int M_, int N_, int G_, int c_) { nM = M_ / BM; nN = N_ / BM; nwg = nM * nN; G = G_; c = c_; }
    __device__ bool next(int i, Unit& u) const {
        const long L = (long)i * G + c; if (L >= nwg) return false;
        int wgid = (int)L; { const int q = nwg / NXCD, r = nwg % NXCD, xcd = wgid % NXCD, off = wgid / NXCD; wgid = (xcd < r ? xcd * (q + 1) : r * (q + 1) + (xcd - r) * q) + off; }
        const int nig = WGM * nN, gid = wgid / nig, fm = gid * WGM, gsz = (nM - fm) < WGM ? (nM - fm) : WGM;
        u.pm = fm + ((wgid % nig) % gsz); u.pn = (wgid % nig) / gsz; return true;
    }
};
__device__ __forceinline__ unsigned cvt_pk_bf16(float lo, float hi) { unsigned r; asm volatile("v_cvt_pk_bf16_f32 %0, %1, %2" : "=v"(r) : "v"(lo), "v"(hi)); return r; }
__device__ __forceinline__ uint2 pack4(f32x4 v) { uint2 o; o.x = cvt_pk_bf16(v[0], v[1]); o.y = cvt_pk_bf16(v[2], v[3]); return o; }
__device__ __forceinline__ f32x4 unpack4(uint2 w) { f32x4 v; v[0] = __uint_as_float(w.x << 16); v[1] = __uint_as_float(w.x & 0xffff0000u); v[2] = __uint_as_float(w.y << 16); v[3] = __uint_as_float(w.y & 0xffff0000u); return v; }
__device__ __forceinline__ float fsigm(float x) { return __builtin_amdgcn_rcpf(1.f + __builtin_amdgcn_exp2f(-1.4426950408889634f * x)); }
__device__ __forceinline__ f32x4 silu4(f32x4 x) { f32x4 r; for (int i = 0; i < 4; ++i) r[i] = x[i] * fsigm(x[i]); return r; }
__device__ __forceinline__ f32x4 sigm4(f32x4 x) { f32x4 r; for (int i = 0; i < 4; ++i) r[i] = fsigm(x[i]); return r; }

enum { EK_GU = 0, EK_RES = 1, EK_WIN = 2, EK_GATE = 3, EK_BR = 4, EK_PP = 5, EK_PLE = 6 };
struct UEpi {
    static constexpr bool PERM = false;
    int kind, mid_t; float sc;
    const float* ss; float* ssout; const float* res; float* H; bf16_t* hb; bf16_t* o;
    const float* cs64; const float* cs32; bf16_t *yb, *ak, *av, *avt, *iq, *ik, *rq, *rk, *rv; float* iw;
    const bf16_t *ga, *gb; bf16_t *ppb, *h4b;
    const PG8_LAS float* rs_tab;
    __device__ __forceinline__ void rope_store(bf16_t* p1, bf16_t* p2, f32x4 a, f32x4 b, const float* cs, const float* sn) const {
        const f32x4 c = *(const f32x4*)cs, s = *(const f32x4*)sn;
        *(uint2*)p1 = pack4(a * c - b * s); *(uint2*)p2 = pack4(b * c + a * s);
    }
    __device__ __forceinline__ void mid(f32x4 (&acc)[2][2][4][2], const Unit& u, int wr, int wc, int fr, int fq) const {
#pragma unroll
        for (int ai = 0; ai < 2; ++ai)
#pragma unroll
            for (int m = 0; m < 4; ++m) { const int row = u.pm * BM + ai * HALF + wr * 64 + m * 16 + fr;
#pragma unroll
                for (int bj = 0; bj < 2; ++bj)
#pragma unroll
                    for (int n = 0; n < 2; ++n) { const size_t idx = (size_t)row * D + u.pn * BM + bj * HALF + wc * 32 + n * 16 + fq * 4;
                        const f32x4 a = unpack4(*(const uint2*)(ga + idx)), b = unpack4(*(const uint2*)(gb + idx));
                        f32x4 r; for (int i = 0; i < 4; ++i) r[i] = a[i] * __builtin_amdgcn_rcpf(b[i]);
                        acc[ai][bj][m][n] = acc[ai][bj][m][n] * r; }
                asm volatile("" ::: "memory"); }
    }
    __device__ __forceinline__ void row_scales(float (&rs)[8], int ui, int wr, int fr) const {
#pragma unroll
        for (int j = 0; j < 8; ++j) rs[j] = rs_tab[ui * 256 + (j >> 2) * HALF + wr * 64 + (j & 3) * 16 + fr];
    }
#define EPI_ROWS(...) _Pragma("unroll") for (int ai = 0; ai < 2; ++ai) _Pragma("unroll") for (int m = 0; m < 4; ++m) { const int row = u.pm * BM + ai * HALF + wr * 64 + m * 16 + fr; \
        _Pragma("unroll") for (int n = 0; n < 2; ++n) { const int c0 = wc * 32 + n * 16 + fq * 4; __VA_ARGS__ } if (m & 1) asm volatile("" ::: "memory"); }
    __device__ __forceinline__ void epi_gu(const f32x4 (&acc)[2][2][4][2], const Unit& u, int wr, int wc, int fr, int fq, int ui) const {
        float rs[8]; row_scales(rs, ui, wr, fr); const int t = u.pn;
        EPI_ROWS({ const float r = rs[ai * 4 + m]; *(uint2*)(o + (size_t)row * FF + t * 128 + c0) = pack4(silu4(acc[ai][0][m][n] * r) * (acc[ai][1][m][n] * r)); })
    }
    __device__ __forceinline__ void epi_gate(const f32x4 (&acc)[2][2][4][2], const Unit& u, int wr, int wc, int fr, int fq, int ui) const {
        float rs[8]; row_scales(rs, ui, wr, fr); const int t = u.pn;
        EPI_ROWS({ const float r = rs[ai * 4 + m]; bf16_t* p = o + (size_t)row * D + t * BM + c0; *(uint2*)p = pack4(sigm4(acc[ai][0][m][n] * r)); *(uint2*)(p + HALF) = pack4(sigm4(acc[ai][1][m][n] * r)); })
    }
    __device__ __forceinline__ void epi_br(const f32x4 (&acc)[2][2][4][2], const Unit& u, int wr, int wc, int fr, int fq, int ui) const {
        const int t = u.pn;
        EPI_ROWS({ const size_t i0 = (size_t)row * D + t * BM + c0, i1 = i0 + HALF;
            *(uint2*)(o + i0) = pack4(acc[ai][0][m][n] * unpack4(*(const uint2*)(gb + i0))); *(uint2*)(o + i1) = pack4(acc[ai][1][m][n] * unpack4(*(const uint2*)(gb + i1))); })
    }
    __device__ __forceinline__ void epi_pp(const f32x4 (&acc)[2][2][4][2], const Unit& u, int wr, int wc, int fr, int fq, int ui) const {
        const int t = u.pn;
        EPI_ROWS({ const size_t i0 = (size_t)row * D + t * BM + c0; *(uint2*)(ppb + i0) = pack4(acc[ai][0][m][n]); *(uint2*)(ppb + i0 + HALF) = pack4(acc[ai][1][m][n]); })
    }
    __device__ __forceinline__ void epi_res(const f32x4 (&acc)[2][2][4][2], const Unit& u, int wr, int wc, int fr, int fq, int ui) const {
        const int t = u.pn;
#pragma unroll
        for (int ai = 0; ai < 2; ++ai)
#pragma unroll
            for (int m = 0; m < 4; ++m) { const int row = u.pm * BM + ai * HALF + wr * 64 + m * 16 + fr; float ssq = 0.f;
#pragma unroll
                for (int n = 0; n < 2; ++n) { const int c0 = wc * 32 + n * 16 + fq * 4; const size_t i0 = (size_t)row * D + t * BM + c0, i1 = i0 + HALF;
                    const f32x4 h0 = unpack4(*(const uint2*)(hb + i0)) + acc[ai][0][m][n] * sc, h1 = unpack4(*(const uint2*)(hb + i1)) + acc[ai][1][m][n] * sc;
                    *(uint2*)(hb + i0) = pack4(h0); *(uint2*)(hb + i1) = pack4(h1);
                    ssq += (h0[0] * h0[0] + h0[1] * h0[1]) + (h0[2] * h0[2] + h0[3] * h0[3]) + (h1[0] * h1[0] + h1[1] * h1[1]) + (h1[2] * h1[2] + h1[3] * h1[3]); }
                ssq += __shfl_xor(ssq, 16); ssq += __shfl_xor(ssq, 32);
                if (fq == 0) ssout[(size_t)row * 16 + t * 4 + wc] = ssq;
                if (m == 3) asm volatile("" ::: "memory"); }
    }
    __device__ __forceinline__ void epi_ple(const f32x4 (&acc)[2][2][4][2], const Unit& u, int wr, int wc, int fr, int fq, int ui) const {
        float rs[8]; row_scales(rs, ui, wr, fr); const int t = u.pn;
#pragma unroll
        for (int ai = 0; ai < 2; ++ai)
#pragma unroll
            for (int m = 0; m < 4; ++m) { const int row = u.pm * BM + ai * HALF + wr * 64 + m * 16 + fr; float ssq = 0.f; const float r = rs[ai * 4 + m];
#pragma unroll
                for (int n = 0; n < 2; ++n) { const int c0 = wc * 32 + n * 16 + fq * 4; const size_t i0 = (size_t)row * D + t * BM + c0, i1 = i0 + HALF;
                    const f32x4 h0 = unpack4(*(const uint2*)(hb + i0)) + sigm4(acc[ai][0][m][n] * r) * unpack4(*(const uint2*)(ppb + i0)), h1 = unpack4(*(const uint2*)(hb + i1)) + sigm4(acc[ai][1][m][n] * r) * unpack4(*(const uint2*)(ppb + i1));
                    *(uint2*)(h4b + i0) = pack4(h0); *(uint2*)(h4b + i1) = pack4(h1);
                    ssq += (h0[0] * h0[0] + h0[1] * h0[1]) + (h0[2] * h0[2] + h0[3] * h0[3]) + (h1[0] * h1[0] + h1[1] * h1[1]) + (h1[2] * h1[2] + h1[3] * h1[3]); }
                ssq += __shfl_xor(ssq, 16); ssq += __shfl_xor(ssq, 32);
                if (fq == 0) ssout[(size_t)row * 16 + t * 4 + wc] = ssq;
                if (m == 3) asm volatile("" ::: "memory"); }
    }
    __device__ __forceinline__ void epi_win(const f32x4 (&acc)[2][2][4][2], const Unit& u, int wr, int wc, int fr, int fq, int ui) const {
        float rs[8]; row_scales(rs, ui, wr, fr); const int t = u.pn;
        EPI_ROWS({ const float r = rs[ai * 4 + m]; const f32x4 a = acc[ai][0][m][n] * r, b = acc[ai][1][m][n] * r; const int d0 = n * 16 + fq * 4;
            if (t < 2 || t == 3 || t == 4) {
                const int head = 4 * (t < 2 ? t : t - 3) + wc;
                bf16_t* p = (t < 2 ? yb + (size_t)row * 1536 : iq + (size_t)row * 512) + head * 64 + d0;
                rope_store(p, p + 32, a, b, cs32 + (size_t)row * 64 + d0, cs32 + (size_t)row * 64 + 32 + d0);
            } else if (t == 2) {
                if (wc < 2) { bf16_t* p = (wc == 0 ? ak : ik) + (size_t)row * 64 + d0; rope_store(p, p + 32, a, b, cs32 + (size_t)row * 64 + d0, cs32 + (size_t)row * 64 + 32 + d0); }
                else { *(uint2*)(av + (size_t)row * 64 + (wc - 2) * 32 + d0) = pack4(a);
                       { bf16_t* tp = avt + ((size_t)(row >> 11) * 64 + (wc - 2) * 32 + d0) * SEQ + (row & 2047);
                         tp[0] = f2bf(a[0]); tp[SEQ] = f2bf(a[1]); tp[2 * SEQ] = f2bf(a[2]); tp[3 * SEQ] = f2bf(a[3]); }
                       if (wc == 2 && n == 0 && fq < 2) *(f32x4*)(iw + (size_t)row * 8 + fq * 4) = b; }
            } else if (t < 9) {
                const int head = 2 * (t < 7 ? t - 5 : t - 7) + (wc >> 1), d1 = (wc & 1) * 32 + d0;
                bf16_t* p = (t < 7 ? rq : rk) + (size_t)row * 512 + head * 128 + d1;
                rope_store(p, p + 64, a, b, cs64 + (size_t)row * 128 + d1, cs64 + (size_t)row * 128 + 64 + d1);
            } else if (t < 13) {
                bf16_t* p = rv + (size_t)row * 1024 + 256 * (t - 9) + c0; *(uint2*)p = pack4(a); *(uint2*)(p + HALF) = pack4(b);
            } else {
                bf16_t* p = yb + (size_t)row * 1536 + 512 + 256 * (t - 13) + c0; *(uint2*)p = pack4(silu4(a)); *(uint2*)(p + HALF) = pack4(silu4(b));
            } })
    }
#undef EPI_ROWS
    __device__ __forceinline__ void operator()(const f32x4 (&acc)[2][2][4][2], const Unit& u, int wr, int wc, int fr, int fq, int ui) const {
        if (kind == EK_GU) epi_gu(acc, u, wr, wc, fr, fq, ui);
        else if (kind == EK_RES) epi_res(acc, u, wr, wc, fr, fq, ui);
        else if (kind == EK_WIN) epi_win(acc, u, wr, wc, fr, fq, ui);
        else if (kind == EK_GATE) epi_gate(acc, u, wr, wc, fr, fq, ui);
        else if (kind == EK_BR) epi_br(acc, u, wr, wc, fr, fq, ui);
        else if (kind == EK_PP) epi_pp(acc, u, wr, wc, fr, fq, ui);
        else epi_ple(acc, u, wr, wc, fr, fq, ui);
    }
};

template <bool MID, class Epi, class Sched>
__device__ __forceinline__ void gemm_phase(PG8_LAS unsigned char* lds, const Gemm g, const Sched& S, const Epi& E, const int tid) {
    const int wid = __builtin_amdgcn_readfirstlane(tid >> 6), lane = tid & 63, wr = wid >> 2, wc = wid & 3, fr = lane & 15, fq = lane >> 4;
    const int K = g.K, nt = K / BK;
    unsigned voffA[2], voffB[2];
#pragma unroll
    for (int i = 0; i < 2; ++i) { int R, C; stage_rc(tid * 16 + i * 8192, R, C); voffA[i] = (unsigned)(R * K + C) * 2u; voffB[i] = voffA[i]; }
    const size_t kstep = (size_t)(BK * 2);
    const size_t hstep = (size_t)HALF * K * 2;
    const size_t tstep = 2 * hstep;
    const unsigned ldsw = (unsigned)wid * 1024u;
    const int aoff = lds_byte(wr * 64 + fr, fq * 8), boff = lds_byte(wc * 32 + fr, fq * 8);
#define PG8_SA(b, h) (((b) * 2 + (h)) * HTB)
#define PG8_SB(b, h) ((4 + (b) * 2 + (h)) * HTB)
#define PG8_STAGE(bufoff, gbase, voff) do { _Pragma("unroll") for (int _i = 0; _i < 2; ++_i) \
        __builtin_amdgcn_global_load_lds((const unsigned*)((const char*)(gbase) + (voff)[_i]), (PG8_LAS unsigned*)(lds + (bufoff) + ldsw + _i * 8192), 16, 0, 0); } while (0)
#define PG8_LDA(dst, b, h) do { _Pragma("unroll") for (int m = 0; m < 4; ++m) _Pragma("unroll") for (int k = 0; k < 2; ++k) dst[m][k] = *(const PG8_LAS bf16x8*)(lds + PG8_SA(b, h) + aoff + m * 2048 + k * 1024); } while (0)
#define PG8_LDB(dst, b, h) do { _Pragma("unroll") for (int n = 0; n < 2; ++n) _Pragma("unroll") for (int k = 0; k < 2; ++k) dst[n][k] = *(const PG8_LAS bf16x8*)(lds + PG8_SB(b, h) + boff + n * 2048 + k * 1024); } while (0)
#define PG8_MMA(ai, bj, At, Bt) do { __builtin_amdgcn_s_setprio(1); _Pragma("unroll") for (int m = 0; m < 4; ++m) _Pragma("unroll") for (int n = 0; n < 2; ++n) _Pragma("unroll") for (int k = 0; k < 2; ++k) \
        acc[ai][bj][m][n] = __builtin_amdgcn_mfma_f32_16x16x32_bf16(Bt[n][k], At[m][k], acc[ai][bj][m][n], 0, 0, 0); __builtin_amdgcn_s_setprio(0); } while (0)
#define PG8_WAIT_V(n) asm volatile("s_waitcnt vmcnt(" #n ")" ::: "memory")
#define PG8_WAIT_L(n) asm volatile("s_waitcnt lgkmcnt(" #n ")" ::: "memory")
#define PG8_BAR __builtin_amdgcn_s_barrier()
#define PG8_SCHED __builtin_amdgcn_sched_barrier(0)
    Unit cur, nxt; int ui = 0;
    if (!S.next(0, cur)) return;
    if (E.ss) {
        Unit tu; PG8_LAS float* tab = (PG8_LAS float*)E.rs_tab;
        for (int i = 0; S.next(i, tu); ++i) { const int row = tu.pm * BM + (tid >> 1);
            const f32x4 a = *(const f32x4*)(E.ss + (size_t)row * 16 + (tid & 1) * 8), b = *(const f32x4*)(E.ss + (size_t)row * 16 + (tid & 1) * 8 + 4);
            float s = ((a[0] + a[1]) + (a[2] + a[3])) + ((b[0] + b[1]) + (b[2] + b[3])); s += __shfl_xor(s, 1);
            if ((tid & 1) == 0) tab[i * 256 + (tid >> 1)] = rsqrtf(s * (1.f / 1024.f) + EPS); }
    }
    f32x4 acc[2][2][4][2];
#pragma unroll
    for (int a = 0; a < 2; ++a)
#pragma unroll
        for (int b = 0; b < 2; ++b)
#pragma unroll
            for (int m = 0; m < 4; ++m)
#pragma unroll
                for (int n = 0; n < 2; ++n) acc[a][b][m][n] = (f32x4){0.f, 0.f, 0.f, 0.f};
    bf16x8 At[4][2], B0[2][2], B1[2][2];
    const char* cA = (const char*)g.A + (size_t)cur.pm * tstep; const char* cB = (const char*)g.Bt + (size_t)cur.pn * tstep;
    PG8_STAGE(PG8_SB(0, 0), cB, voffB); PG8_STAGE(PG8_SB(0, 1), cB + hstep, voffB); PG8_STAGE(PG8_SA(0, 0), cA, voffA); PG8_STAGE(PG8_SA(0, 1), cA + hstep, voffA);
    if (wr == 1) PG8_BAR;
    PG8_WAIT_V(2); PG8_BAR;
    PG8_STAGE(PG8_SB(1, 0), cB + kstep, voffB); PG8_STAGE(PG8_SA(1, 0), cA + kstep, voffA); PG8_STAGE(PG8_SB(1, 1), cB + hstep + kstep, voffB);
    PG8_WAIT_V(6); PG8_BAR;
    for (;;) {
        const bool has_next = S.next(ui + 1, nxt);
        const char* nA = has_next ? (const char*)g.A + (size_t)nxt.pm * tstep : cA; const char* nB = has_next ? (const char*)g.Bt + (size_t)nxt.pn * tstep : cB;
#define PG8_KITER(t) do { \
            const bool last = ((t) == nt - 2); \
            const char* a1 = cA + (size_t)((t) + 1) * kstep; \
            const char* a2 = last ? nA : cA + (size_t)((t) + 2) * kstep; const char* b2 = last ? nB : cB + (size_t)((t) + 2) * kstep; \
            const char* a3 = a2 + kstep; const char* b3 = b2 + kstep; \
            PG8_LDB(B0, 0, 0); PG8_LDB(B1, 0, 1); PG8_SCHED; PG8_LDA(At, 0, 0); PG8_STAGE(PG8_SA(1, 1), a1 + hstep, voffA); \
            PG8_WAIT_V(8); PG8_WAIT_L(0); PG8_BAR; PG8_MMA(0, 0, At, B0); PG8_MMA(0, 1, At, B1); PG8_BAR; PG8_SCHED; \
            PG8_LDA(At, 0, 1); PG8_STAGE(PG8_SB(0, 0), b2, voffB); PG8_STAGE(PG8_SB(0, 1), b2 + hstep, voffB); PG8_STAGE(PG8_SA(0, 0), a2, voffA); \
            PG8_WAIT_V(8); PG8_WAIT_L(0); PG8_BAR; PG8_MMA(1, 0, At, B0); PG8_MMA(1, 1, At, B1); PG8_BAR; PG8_SCHED; \
            PG8_LDB(B0, 1, 0); PG8_LDB(B1, 1, 1); PG8_SCHED; PG8_LDA(At, 1, 0); PG8_STAGE(PG8_SA(0, 1), a2 + hstep, voffA); \
            PG8_WAIT_V(8); PG8_WAIT_L(0); PG8_BAR; PG8_MMA(0, 0, At, B0); PG8_MMA(0, 1, At, B1); PG8_BAR; PG8_SCHED; \
            PG8_LDA(At, 1, 1); PG8_STAGE(PG8_SB(1, 0), b3, voffB); PG8_STAGE(PG8_SB(1, 1), b3 + hstep, voffB); PG8_STAGE(PG8_SA(1, 0), a3, voffA); \
            PG8_WAIT_V(8); PG8_WAIT_L(0); PG8_BAR; PG8_MMA(1, 0, At, B0); PG8_MMA(1, 1, At, B1); PG8_BAR; PG8_SCHED; } while (0)
        if constexpr (MID) {
            const int tm = E.mid_t;
            for (int t = 0; t < tm; t += 2) PG8_KITER(t);
            E.mid(acc, cur, wr, wc, fr, fq);
            for (int t = tm; t < nt; t += 2) PG8_KITER(t);
        } else {
            for (int t = 0; t < nt; t += 2) PG8_KITER(t);
        }
        if (wr == 0) PG8_BAR;
        E(acc, cur, wr, wc, fr, fq, ui);
        if (!has_next) break;
#pragma unroll
        for (int a = 0; a < 2; ++a)
#pragma unroll
            for (int b = 0; b < 2; ++b)
#pragma unroll
                for (int m = 0; m < 4; ++m)
#pragma unroll
                    for (int n = 0; n < 2; ++n) acc[a][b][m][n] = (f32x4){0.f, 0.f, 0.f, 0.f};
        cur = nxt; cA = nA; cB = nB; ++ui;
        if (wr == 1) PG8_BAR;
    }
    PG8_WAIT_V(0);
    PG8_BAR;
#undef PG8_KITER
#undef PG8_SA
#undef PG8_SB
#undef PG8_STAGE
#undef PG8_LDA
#undef PG8_LDB
#undef PG8_MMA
#undef PG8_WAIT_V
#undef PG8_WAIT_L
#undef PG8_BAR
#undef PG8_SCHED
}
}

#define LAS __attribute__((address_space(3)))
#define XB_TMO      128
#define XB_XCNT(j)  (256  + 64 * (j))
#define XB_XSUB(j)  (1280 + 64 * (j))
#define XB_XGEN(j)  (2304 + 64 * (j))
#define XB_TOP      3328
#define XB_TOPGEN   3392
#define XCD_BAR_WORDS 3456
#define XB_SPIN_CAP (1u << 24)
__device__ __forceinline__ unsigned xb_ld(unsigned* p)              { return __hip_atomic_load(p, __ATOMIC_RELAXED, __HIP_MEMORY_SCOPE_AGENT); }
__device__ __forceinline__ unsigned xb_add(unsigned* p, unsigned v) { return __hip_atomic_fetch_add(p, v, __ATOMIC_RELAXED, __HIP_MEMORY_SCOPE_AGENT); }
__device__ __forceinline__ unsigned xb_xcc_id() { return (unsigned)__builtin_amdgcn_s_getreg((3 << 11) | 20) & 0xFu; }
#define XB_SPIN(cond, bar) do { unsigned _sp = 0; while (cond) { __builtin_amdgcn_s_sleep(1); \
    if ((++_sp & 255u) == 0u) { if (xb_ld(&(bar)[XB_TMO])) break; if (_sp > XB_SPIN_CAP) { atomicAdd(&(bar)[XB_TMO], 1u); break; } } } } while (0)
struct XcdBarrier { unsigned* bar; unsigned x; volatile LAS unsigned* st; };
__device__ __forceinline__ XcdBarrier xcd_barrier_post(unsigned* bar, volatile LAS unsigned* st, const int tid) {
    XcdBarrier b; b.bar = bar; b.x = xb_xcc_id(); b.st = st;
    if (tid == 0) (void)xb_add(&bar[XB_XCNT(b.x)], 1u);
    return b;
}
__device__ __forceinline__ void xcd_barrier_complete(unsigned* bar, unsigned x, unsigned& nloc, unsigned& nx) {
    const unsigned G = gridDim.x * gridDim.y * gridDim.z;
    unsigned sum, cnt, mine, sp = 0u;
    for (;;) {
        sum = 0u; cnt = 0u; mine = 0u;
#pragma unroll
        for (unsigned j = 0; j < 16; ++j) { const unsigned c = xb_ld(&bar[XB_XCNT(j)]); sum += c; cnt += (c > 0u) ? 1u : 0u; mine = (j == x) ? c : mine; }
        if (sum == G) break;
        __builtin_amdgcn_s_sleep(1);
        if ((++sp & 255u) == 0u) { if (xb_ld(&bar[XB_TMO])) break; if (sp > XB_SPIN_CAP) { atomicAdd(&bar[XB_TMO], 1u); break; } }
    }
    nloc = mine > 0u ? mine : 1u; nx = cnt > 0u ? cnt : 1u;
}
__device__ __forceinline__ void xcd_barrier(const XcdBarrier& b, const int tid) {
    asm volatile("s_waitcnt vmcnt(0)" ::: "memory");
    __syncthreads();
    if (tid == 0) {
        unsigned* bar = b.bar;
        __builtin_amdgcn_s_waitcnt(0);
        unsigned nloc = b.st[0], nx = b.st[1];
        if (nloc == 0u) { xcd_barrier_complete(bar, b.x, nloc, nx); b.st[0] = nloc; b.st[1] = nx; }
        const unsigned old = xb_add(&bar[XB_XSUB(b.x)], 1u);
        const unsigned gen = old / nloc;
        if (old + 1u == (gen + 1u) * nloc) {
            __builtin_amdgcn_fence(__ATOMIC_RELEASE, "agent");
            asm volatile("s_waitcnt vmcnt(0)" ::: "memory");
            const unsigned og = xb_add(&bar[XB_TOP], 1u);
            const unsigned tg = og / nx;
            if (og + 1u == (tg + 1u) * nx) xb_add(&bar[XB_TOPGEN], 1u);
            else XB_SPIN(xb_ld(&bar[XB_TOPGEN]) == tg, bar);
            __builtin_amdgcn_fence(__ATOMIC_ACQUIRE, "agent");
            xb_add(&bar[XB_XGEN(b.x)], 1u);
            asm volatile("s_waitcnt vmcnt(0)" ::: "memory");
        } else {
            XB_SPIN(xb_ld(&bar[XB_XGEN(b.x)]) == gen, bar);
            __builtin_amdgcn_fence(__ATOMIC_ACQUIRE, "agent");
            asm volatile("s_waitcnt vmcnt(0)" ::: "memory");
        }
    }
    __syncthreads();
}

template <class F> __device__ __forceinline__ void p0_item(const F& f, bf16_t* out, int ldo, int N, LAS float* scr, int item, int lane) {
    const int nblk = N / 32, kb = item / nblk, nb = item % nblk, k0 = 64 * kb, n0 = 32 * nb;
    f32x4 v[8];
#pragma unroll
    for (int i = 0; i < 8; ++i) v[i] = f.f4(n0 + 4 * (lane & 7), k0 + 8 * i + (lane >> 3));
#pragma unroll
    for (int i = 0; i < 8; ++i) { LAS float* d = scr + (8 * i + (lane >> 3)) * 33 + 4 * (lane & 7); d[0] = v[i][0]; d[1] = v[i][1]; d[2] = v[i][2]; d[3] = v[i][3]; }
    asm volatile("s_waitcnt lgkmcnt(0)" ::: "memory");
    const int c = lane & 7;
#pragma unroll
    for (int j = 0; j < 4; ++j) { const int n = (lane >> 3) + 8 * j; const LAS float* s = scr + (8 * c) * 33 + n;
        u32x4 o; o.x = pg8::cvt_pk_bf16(s[0 * 33], s[1 * 33]); o.y = pg8::cvt_pk_bf16(s[2 * 33], s[3 * 33]); o.z = pg8::cvt_pk_bf16(s[4 * 33], s[5 * 33]); o.w = pg8::cvt_pk_bf16(s[6 * 33], s[7 * 33]);
        *(u32x4*)(out + (size_t)(n0 + n) * ldo + k0 + 8 * c) = o; }
    asm volatile("s_waitcnt lgkmcnt(0)" ::: "memory");
}


__device__ __forceinline__ float dot64(const LAS float* q, const u32x4 (&kw)[8]) {
    float d = 0.f;
#pragma unroll
    for (int i8 = 0; i8 < 8; ++i8) { const u32x4 w = kw[i8]; const LAS float* qq = q + i8 * 8;
        d += (qq[0] * __uint_as_float(w.x << 16) + qq[1] * __uint_as_float(w.x & 0xffff0000u)) + (qq[2] * __uint_as_float(w.y << 16) + qq[3] * __uint_as_float(w.y & 0xffff0000u))
           + (qq[4] * __uint_as_float(w.z << 16) + qq[5] * __uint_as_float(w.z & 0xffff0000u)) + (qq[6] * __uint_as_float(w.w << 16) + qq[7] * __uint_as_float(w.w & 0xffff0000u)); }
    return d;
}
__device__ __forceinline__ void ld_k64(const bf16_t* kp, u32x4 (&kw)[8]) {
#pragma unroll
    for (int i = 0; i < 8; ++i) kw[i] = *(const u32x4*)(kp + 8 * i);
}
__device__ __forceinline__ int half_sum_i(int v, LAS int* red, int t) {
    int s = v;
#pragma unroll
    for (int o = 1; o < 64; o <<= 1) s += __shfl_xor(s, o);
    __syncthreads();
    if ((t & 63) == 0) red[t >> 6] = s;
    __syncthreads();
    return (red[0] + red[1]) + (red[2] + red[3]);
}
__device__ __forceinline__ float half_sum_f(float v, LAS float* red, int t) {
    const float s = wave_sum(v);
    __syncthreads();
    if ((t & 63) == 0) red[t >> 6] = s;
    __syncthreads();
    return (red[0] + red[1]) + (red[2] + red[3]);
}
__device__ __forceinline__ void mk_index_select(LAS unsigned char* l, int tok, int t, const bf16_t* IQ, const bf16_t* IK, const float* IW) {
    LAS float* q = (LAS float*)l; LAS float* w = (LAS float*)(l + 2048); LAS int* red = (LAS int*)(l + 2112); LAS unsigned* key = (LAS unsigned*)(l + 4096); LAS unsigned* msk = (LAS unsigned*)(l + 12288);
    const int b = tok >> 11, s = tok & 2047, L = ((s >> 6) + 1) << 6;
    __syncthreads();
#pragma unroll 1
    for (int i = t; i < 512; i += 256) q[i] = bf2f(IQ[(size_t)tok * 512 + i]);
    if (t < 8) w[t] = IW[(size_t)tok * 8 + t];
    if (t < 64) msk[t] = 0u;
    __syncthreads();
#pragma unroll 1
    for (int j = t; j < L; j += 256) {
        asm volatile("" ::: "memory");
        u32x4 kw[8]; ld_k64(IK + (size_t)(b * SEQ + j) * 64, kw);
        float sc = 0.f;
#pragma unroll 1
        for (int hh = 0; hh < 8; ++hh) { asm volatile("" ::: "memory"); sc += w[hh] * fmaxf(dot64(q + hh * 64, kw), 0.f); }
        sc += 0.f;
        unsigned u = __float_as_uint(sc); u ^= (u >> 31) ? 0xffffffffu : 0x80000000u;
        key[j] = u;
    }
    __syncthreads();
    if (L <= 256) {
#pragma unroll 1
        for (int j = t; j < L; j += 256) atomicOr((unsigned*)&msk[j >> 5], 1u << (j & 31)); }
    else {
        unsigned T = 0u;
#pragma unroll 1
        for (int bit = 31; bit >= 0; --bit) {
            const unsigned cand = T | (1u << bit); int c = 0;
#pragma unroll 1
            for (int j = t; j < L; j += 256) c += key[j] >= cand ? 1 : 0;
            if (half_sum_i(c, red, t) >= 256) T = cand;
        }
        int c = 0;
#pragma unroll 1
        for (int j = t; j < L; j += 256) { if (key[j] > T) { c++; atomicOr((unsigned*)&msk[j >> 5], 1u << (j & 31)); } }
        int need = 256 - half_sum_i(c, red, t);
        if (t == 0) {
#pragma unroll 1
            for (int j = 0; j < L && need > 0; ++j) if (key[j] == T) { msk[j >> 5] |= 1u << (j & 31); --need; } }
    }
    __syncthreads();
}
__device__ __forceinline__ void mk_attn_naive(LAS unsigned char* l, int tok, int t, bf16_t* YB, const bf16_t* AK, const bf16_t* AV) {
    LAS float* q = (LAS float*)l; LAS float* rinv = (LAS float*)(l + 2176); LAS unsigned* msk = (LAS unsigned*)(l + 12288); LAS float* lg = (LAS float*)(l + 16384);
    const int b = tok >> 11, s = tok & 2047, L = ((s >> 6) + 1) << 6, wid = t >> 6, lane = t & 63;
#pragma unroll 1
    for (int i = t; i < 512; i += 256) q[i] = bf2f(YB[(size_t)tok * 1536 + i]);
    __syncthreads();
#pragma unroll 1
    for (int hg = 0; hg < 2; ++hg) {
#pragma unroll 1
        for (int j = t; j < L; j += 256) {
            if ((msk[j >> 5] >> (j & 31)) & 1u) {
                asm volatile("" ::: "memory");
                u32x4 kw[8]; ld_k64(AK + (size_t)(b * SEQ + j) * 64, kw);
#pragma unroll 1
                for (int hh = 0; hh < 4; ++hh) { asm volatile("" ::: "memory"); lg[hh * 2048 + j] = dot64(q + (hg * 4 + hh) * 64, kw); }
            } else {
#pragma unroll
                for (int hh = 0; hh < 4; ++hh) lg[hh * 2048 + j] = -1e30f;
            }
        }
        __syncthreads();
        {
            float m = -1e30f;
#pragma unroll 1
            for (int j = lane; j < L; j += 64) m = fmaxf(m, lg[wid * 2048 + j]);
            m = wave_max(m);
            float sum = 0.f;
#pragma unroll 1
            for (int j = lane; j < L; j += 64) { const float x = lg[wid * 2048 + j]; const float p = x > -5e29f ? __expf(x - m) : 0.f; lg[wid * 2048 + j] = p; sum += p; }
            sum = wave_sum(sum);
            if (lane == 0) rinv[wid] = 1.f / sum;
        }
        __syncthreads();
        {
            float o = 0.f;
#pragma unroll 1
            for (int j = 0; j < L; ++j) { const float p = lg[wid * 2048 + j]; if (p != 0.f) o += p * bf2f(AV[(size_t)(b * SEQ + j) * 64 + lane]); }
            YB[(size_t)tok * 1536 + (hg * 4 + wid) * 64 + lane] = f2bf(o * rinv[wid]);
        }
        __syncthreads();
    }
}
__device__ __forceinline__ void mk_ret_naive(LAS unsigned char* l, int tok, int h, int t, const bf16_t* RQ, const bf16_t* RK, const bf16_t* RV, bf16_t* YB) {
    LAS float* q = (LAS float*)l; LAS float* sc = (LAS float*)(l + 1024); LAS float* red = (LAS float*)(l + 2112);
    const int b = tok >> 11, s = tok & 2047, L = ((s >> 6) + 1) << 6;
    __syncthreads();
    if (t < 128) q[t] = bf2f(RQ[(size_t)tok * 512 + h * 128 + t]);
    __syncthreads();
    const float lg2 = log2f(1.f - exp2f(-5.f - (float)h));
    float y = 0.f;
#pragma unroll 1
    for (int j0 = 0; j0 < L; j0 += 256) {
        const int j = j0 + t; float sv = 0.f;
        if (j < L) {
            const bf16_t* kr = RK + (size_t)(b * SEQ + j) * 512 + h * 128;
            asm volatile("" ::: "memory");
            float d; { u32x4 kw[8]; ld_k64(kr, kw); d = dot64(q, kw); } { u32x4 kw[8]; ld_k64(kr + 64, kw); d += dot64(q + 64, kw); }
            const int dist = s > j ? s - j : j - s;
            sv = d * exp2f(lg2 * (float)dist);
        }
        sc[t] = sv;
        __syncthreads();
        const int n = (L - j0) < 256 ? (L - j0) : 256;
#pragma unroll 1
        for (int jj = 0; jj < n; ++jj) y += sc[jj] * bf2f(RV[(size_t)(b * SEQ + j0 + jj) * 1024 + h * 256 + t]);
        __syncthreads();
    }
    const float mean = half_sum_f(y, red, t) * (1.f / 256.f);
    const float dv = y - mean;
    const float var = half_sum_f(dv * dv, red, t) * (1.f / 256.f);
    const float yn = dv * rsqrtf(var + GN_EPS);
    bf16_t* o = YB + (size_t)tok * 1536 + 512 + h * 256 + t;
    *o = f2bf(yn * bf2f(*o));
}

__device__ __forceinline__ int lane_now() { int l; asm volatile("v_mbcnt_lo_u32_b32 %0, -1, 0\n\tv_mbcnt_hi_u32_b32 %0, -1, %0" : "=v"(l)); return l; }
__device__ __forceinline__ unsigned mono_key(float s) { const unsigned u = __float_as_uint(s); return u ^ ((unsigned)((int)u >> 31) | 0x80000000u); }
__device__ __forceinline__ int crow16(int r, int hf) { return (r & 3) + 8 * (r >> 2) + 4 * hf; }
typedef short s16x4_t __attribute__((ext_vector_type(4)));
__device__ __forceinline__ s16x4_t lds_tr16(const LAS unsigned char* p) { return __builtin_bit_cast(s16x4_t, __builtin_amdgcn_ds_read_tr16_b64_v4i16((LAS s16x4_t*)p)); }
__device__ __forceinline__ bf16x8 cat8(s16x4_t lo, s16x4_t hi) { bf16x8 r; r[0] = lo[0]; r[1] = lo[1]; r[2] = lo[2]; r[3] = lo[3]; r[4] = hi[0]; r[5] = hi[1]; r[6] = hi[2]; r[7] = hi[3]; return r; }
__device__ __forceinline__ int row16_sum(int x) {
    x += __builtin_amdgcn_update_dpp(0, x, 0xB1, 0xF, 0xF, true);
    x += __builtin_amdgcn_update_dpp(0, x, 0x4E, 0xF, 0xF, true);
    x += __builtin_amdgcn_update_dpp(0, x, 0x141, 0xF, 0xF, true);
    x += __builtin_amdgcn_update_dpp(0, x, 0x140, 0xF, 0xF, true);
    return x;
}
__device__ __forceinline__ void dsa_unit(LAS unsigned char* lds, int b, int g, const bf16_t* IQ, const bf16_t* IK, const float* IW, bf16_t* YB, const bf16_t* AK, const bf16_t* AV, const int w, const bool do_store = true) {
    const int lane = lane_now(), c = lane & 31, hf = lane >> 5, tid = w * 64 + lane;
    const int tok0 = b * SEQ + 32 * g + 4 * w;
    const int nt = 2 * (g >> 1) + 2, nst = nt >> 1;
    constexpr int RS = 144;
    LAS unsigned* MSK = (LAS unsigned*)lds + w * 256;
    LAS float* wsf = (LAS float*)(lds + 8192) + w * 64;
    LAS unsigned char* KB = lds + 16384; LAS unsigned char* VB = lds + 34816;
    const int srow = tid >> 3, sch = tid & 7;
    unsigned k0[64], k1[64];
    {
        const int ql = 2 * ((c >> 2) & 1) + (c >> 4), head = (c & 3) + 4 * ((c >> 3) & 1);
        bf16x8 aI[4];
#pragma unroll
        for (int s = 0; s < 4; ++s) aI[s] = *(const bf16x8*)(IQ + (size_t)(tok0 + ql) * 512 + head * 64 + 16 * s + 8 * hf);
        const f32x4 wa = *(const f32x4*)(IW + (size_t)(tok0 + 2 * hf) * 8), wb = *(const f32x4*)(IW + (size_t)(tok0 + 2 * hf) * 8 + 4);
        const f32x4 wc4 = *(const f32x4*)(IW + (size_t)(tok0 + 2 * hf + 1) * 8), wd = *(const f32x4*)(IW + (size_t)(tok0 + 2 * hf + 1) * 8 + 4);
        const bf16_t* gsrc = IK + ((size_t)b * SEQ + srow) * 64 + sch * 8;
        u32x4 rkr[2];
        rkr[0] = *(const u32x4*)gsrc;
        if (1 < nst) rkr[1] = *(const u32x4*)(gsrc + (size_t)4096);
        *(LAS u32x4*)(KB + srow * RS + sch * 16) = rkr[0];
        if (2 < nst) rkr[0] = *(const u32x4*)(gsrc + (size_t)2 * 4096);
        __syncthreads();
#define DSA_SCORE(bufoff, sub, j) do { f32x16 acc; _Pragma("unroll") for (int r = 0; r < 16; ++r) acc[r] = 0.f; \
            _Pragma("unroll") for (int s = 0; s < 4; ++s) acc = __builtin_amdgcn_mfma_f32_32x32x16_bf16(aI[s], *(const LAS bf16x8*)(KB + (bufoff) + (32 * (sub) + c) * RS + (16 * s + 8 * hf) * 2), acc, 0, 0, 0); \
            float s0 = 0.f, s1 = 0.f; \
            _Pragma("unroll") for (int r = 0; r < 4; ++r) { s0 = fmaf(wa[r], fmaxf(acc[r], 0.f), s0); s1 = fmaf(wc4[r], fmaxf(acc[8 + r], 0.f), s1); } \
            _Pragma("unroll") for (int r = 0; r < 4; ++r) { s0 = fmaf(wb[r], fmaxf(acc[4 + r], 0.f), s0); s1 = fmaf(wd[r], fmaxf(acc[12 + r], 0.f), s1); } \
            k0[j] = mono_key(s0); k1[j] = mono_key(s1); } while (0)
#pragma unroll
        for (int st = 0; st < 32; ++st) {
            if (st < nst) {
                DSA_SCORE((st & 1) * 9216, 0, 2 * st);
                DSA_SCORE((st & 1) * 9216, 1, 2 * st + 1);
                if (st + 1 < nst) *(LAS u32x4*)(KB + ((st + 1) & 1) * 9216 + srow * RS + sch * 16) = rkr[(st + 1) & 1];
                if (st + 3 < nst) rkr[(st + 1) & 1] = *(const u32x4*)(gsrc + (size_t)(st + 3) * 4096);
                __syncthreads();
            } else { k0[2 * st] = 0u; k1[2 * st] = 0u; k0[2 * st + 1] = 0u; k1[2 * st + 1] = 0u; }
        }
#undef DSA_SCORE
    }
    unsigned T0 = 1u, T1 = 1u;
    if (nt > 8) {
        T0 = 0u; T1 = 0u; bool d0 = false, d1 = false;
        for (int bit = 31; bit >= 0; --bit) {
            const unsigned c0 = T0 | (1u << bit), c1 = T1 | (1u << bit); int n0 = 0, n1 = 0;
#pragma unroll
            for (int j8 = 0; j8 < 8; ++j8) { if (8 * j8 < nt) {
#pragma unroll
                for (int j = 8 * j8; j < 8 * j8 + 8; ++j) { n0 += (k0[j] >= c0) ? 1 : 0; n1 += (k1[j] >= c1) ? 1 : 0; } } }
            n0 = row16_sum(n0); n1 = row16_sum(n1);
            n0 += __shfl_xor(n0, 16); n1 += __shfl_xor(n1, 16);
            if (!d0 && n0 >= 256) T0 = c0;
            if (!d1 && n1 >= 256) T1 = c1;
            d0 = d0 || (n0 == 256); d1 = d1 || (n1 == 256);
            if (__all(d0 && d1)) break;
        }
    }
#pragma unroll
    for (int j = 0; j < 64; ++j) {
        if (j < nt) {
            const unsigned long long m0 = __ballot(k0[j] >= T0), m1 = __ballot(k1[j] >= T1);
            if (lane == 0) { MSK[0 * 64 + j] = (unsigned)m0; MSK[2 * 64 + j] = (unsigned)(m0 >> 32); MSK[1 * 64 + j] = (unsigned)m1; MSK[3 * 64 + j] = (unsigned)(m1 >> 32); }
        }
    }
    asm volatile("s_waitcnt lgkmcnt(0)" ::: "memory");
    {
        const int lane2 = lane_now(), c = lane2 & 31, hf = lane2 >> 5;
        const int trq = (lane2 & 15) >> 2, trp = lane2 & 3, trblk = (lane2 >> 4) & 1;
        bf16x8 bQ[4];
        { const bf16_t* qp = YB + (size_t)(tok0 + (c >> 3)) * 1536 + (c & 7) * 64 + 8 * hf;
#pragma unroll
          for (int s = 0; s < 4; ++s) bQ[s] = *(const bf16x8*)(qp + 16 * s); }
        f32x16 O0, O1;
#pragma unroll
        for (int r = 0; r < 16; ++r) { O0[r] = 0.f; O1[r] = 0.f; }
        float m_run = 0.f, l_run = 0.f; bool seen = false;
        const bf16_t* ksrc = AK + ((size_t)b * SEQ + srow) * 64 + sch * 8;
        const bf16_t* vsrc = AV + ((size_t)b * SEQ + srow) * 64 + sch * 8;
        const LAS unsigned* mrow = MSK + (c >> 3) * 64;
        LAS unsigned char* K2 = lds + 16384; LAS unsigned char* V2 = lds + 53248;
        const int nst4 = (nt + 3) >> 2;
        u32x4 rk0 = *(const u32x4*)ksrc, rk1 = *(const u32x4*)(ksrc + 4096), rv0 = *(const u32x4*)vsrc, rv1 = *(const u32x4*)(vsrc + 4096);
        __syncthreads();
        *(LAS u32x4*)(K2 + srow * RS + sch * 16) = rk0; *(LAS u32x4*)(K2 + (srow + 64) * RS + sch * 16) = rk1;
        *(LAS u32x4*)(V2 + srow * RS + sch * 16) = rv0; *(LAS u32x4*)(V2 + (srow + 64) * RS + sch * 16) = rv1;
        __syncthreads();
        for (int st = 0; st < nst4; ++st) {
            const int bo = (st & 1) * 18432;
            if (st + 1 < nst4) { const size_t go = (size_t)(st + 1) * 8192; rk0 = *(const u32x4*)(ksrc + go); rk1 = *(const u32x4*)(ksrc + go + 4096); rv0 = *(const u32x4*)(vsrc + go); rv1 = *(const u32x4*)(vsrc + go + 4096); }
#pragma unroll
            for (int sub = 0; sub < 4; ++sub) {
                const int j = 4 * st + sub;
                if (j < nt) {
                f32x16 S;
#pragma unroll
                for (int r = 0; r < 16; ++r) S[r] = -m_run;
#pragma unroll
                for (int s = 0; s < 4; ++s) S = __builtin_amdgcn_mfma_f32_32x32x16_bf16(*(const LAS bf16x8*)(K2 + bo + (32 * sub + c) * RS + (16 * s + 8 * hf) * 2), bQ[s], S, 0, 0, 0);
                bf16x8 bV[2][2];
#pragma unroll
                for (int s = 0; s < 2; ++s)
#pragma unroll
                    for (int dh = 0; dh < 2; ++dh) { const LAS unsigned char* p = V2 + bo + (32 * sub + 16 * s + 4 * hf + trq) * RS + (32 * dh + 16 * trblk + 4 * trp) * 2;
                        bV[s][dh] = cat8(lds_tr16(p), lds_tr16(p + 8 * RS)); }
                const unsigned mw = mrow[j] >> (4 * hf);
                float rowmax = -1e30f;
#pragma unroll
                for (int r = 0; r < 16; ++r) { S[r] = __builtin_amdgcn_sbfe(mw, (r & 3) + 8 * (r >> 2), 1) ? S[r] : -1e30f; rowmax = fmaxf(rowmax, S[r]); }
                rowmax = fmaxf(rowmax, __shfl_xor(rowmax, 32));
                const bool has = rowmax > -1e29f;
                if (__any(rowmax > 8.f || (has && !seen))) {
                    const float dl = seen ? fmaxf(rowmax, 0.f) : (has ? rowmax : 0.f), alpha = seen ? __builtin_amdgcn_exp2f(-dl) : 1.f;
                    seen = seen || has;
                    m_run += dl; l_run *= alpha;
#pragma unroll
                    for (int r = 0; r < 16; ++r) S[r] -= dl;
                    if (hf == 0) wsf[c] = alpha;
                    asm volatile("s_waitcnt lgkmcnt(0)" ::: "memory");
#pragma unroll
                    for (int r = 0; r < 16; ++r) { const float a_ = wsf[crow16(r, hf)]; O0[r] *= a_; O1[r] *= a_; }
                    asm volatile("s_waitcnt lgkmcnt(0)" ::: "memory");
                }
                float psum = 0.f;
#pragma unroll
                for (int r = 0; r < 16; ++r) { S[r] = __builtin_amdgcn_exp2f(S[r]); psum += S[r]; }
                l_run += psum;
#pragma unroll
                for (int s = 0; s < 2; ++s) {
                    u32x4 pw; pw.x = pg8::cvt_pk_bf16(S[8 * s + 0], S[8 * s + 1]); pw.y = pg8::cvt_pk_bf16(S[8 * s + 2], S[8 * s + 3]); pw.z = pg8::cvt_pk_bf16(S[8 * s + 4], S[8 * s + 5]); pw.w = pg8::cvt_pk_bf16(S[8 * s + 6], S[8 * s + 7]);
                    const bf16x8 pa = __builtin_bit_cast(bf16x8, pw);
                    O0 = __builtin_amdgcn_mfma_f32_32x32x16_bf16(pa, bV[s][0], O0, 0, 0, 0);
                    O1 = __builtin_amdgcn_mfma_f32_32x32x16_bf16(pa, bV[s][1], O1, 0, 0, 0);
                }
                }
            }
            if (st + 1 < nst4) { const int bn = bo ^ 18432;
                *(LAS u32x4*)(K2 + bn + srow * RS + sch * 16) = rk0; *(LAS u32x4*)(K2 + bn + (srow + 64) * RS + sch * 16) = rk1;
                *(LAS u32x4*)(V2 + bn + srow * RS + sch * 16) = rv0; *(LAS u32x4*)(V2 + bn + (srow + 64) * RS + sch * 16) = rv1; }
            __syncthreads();
        }
        const float l_tot = l_run + __shfl_xor(l_run, 32);
        if (hf == 0) wsf[c] = 1.f / l_tot;
        asm volatile("s_waitcnt lgkmcnt(0)" ::: "memory");
#pragma unroll
        for (int r = 0; r < 16; ++r) { const int cc = crow16(r, hf); const float inv = wsf[cc];
            bf16_t* o = YB + (size_t)(tok0 + (cc >> 3)) * 1536 + (cc & 7) * 64 + c;
            if (do_store) { o[0] = f2bf(O0[r] * inv); o[32] = f2bf(O1[r] * inv); } else { asm volatile("" :: "v"(O0[r] * inv), "v"(O1[r] * inv)); } }
        asm volatile("s_waitcnt lgkmcnt(0)" ::: "memory");
    }
}

__device__ __forceinline__ void ret_item(LAS unsigned char* lds, int b, int h, const bf16_t* RQ, const bf16_t* RK, const bf16_t* RV, bf16_t* YB, const int w, const int n1, const int nf, const bool do_store = true) {
    const int lane = lane_now(), c = lane & 31, hf = lane >> 5, tid = w * 64 + lane;
    constexpr int QS = 272, VS = 528, PS = 144, YSF = 260;
    LAS unsigned char *QI = lds, *KI = lds + 17408, *KD = lds + 34816, *VI = lds + 52224, *PI = lds + 86016; LAS float* YBUF = (LAS float*)lds;
    const float lg2 = log2f(1.f - exp2f(-5.f - (float)h)), g64 = exp2f(lg2 * 64.f);
    const float kf0 = exp2f(lg2 * (float)(63 - (tid >> 4))), kf1 = exp2f(lg2 * (float)(63 - ((tid + 512) >> 4)));
    const int trq = (lane & 15) >> 2, trp = lane & 3, trblk = (lane >> 4) & 1;
    f32x16 S[4];
#pragma unroll
    for (int d = 0; d < 4; ++d)
#pragma unroll
        for (int r = 0; r < 16; ++r) S[d][r] = 0.f;
    u32x4 rq[2], rk[2], rv[4], rg[4];
    const size_t tb0 = (size_t)b * SEQ;
#define RET_LOAD(n) do { const size_t tb = tb0 + 64 * (n); \
        _Pragma("unroll") for (int k = 0; k < 2; ++k) { const int p = tid + 512 * k, row = p >> 4, ch = p & 15; \
            rq[k] = *(const u32x4*)(RQ + (tb + row) * 512 + h * 128 + ch * 8); rk[k] = *(const u32x4*)(RK + (tb + row) * 512 + h * 128 + ch * 8); } \
        _Pragma("unroll") for (int k = 0; k < 4; ++k) { const int p = tid + 512 * k, row = p >> 5, ch = p & 31; rv[k] = *(const u32x4*)(RV + (tb + row) * 1024 + h * 256 + ch * 8); } } while (0)
    if (nf > 0) {
#define RET_LOADKV(n) do { const size_t tb = tb0 + 64 * (n); \
        _Pragma("unroll") for (int k = 0; k < 2; ++k) { const int p = tid + 512 * k, row = p >> 4, ch = p & 15; rk[k] = *(const u32x4*)(RK + (tb + row) * 512 + h * 128 + ch * 8); } \
        _Pragma("unroll") for (int k = 0; k < 4; ++k) { const int p = tid + 512 * k, row = p >> 5, ch = p & 31; rv[k] = *(const u32x4*)(RV + (tb + row) * 1024 + h * 256 + ch * 8); } } while (0)
        RET_LOADKV(0);
        for (int n = 0; n < nf; ++n) {
#pragma unroll
            for (int k = 0; k < 2; ++k) { const int p = tid + 512 * k, row = p >> 4, ch = p & 15; const float f = k == 0 ? kf0 : kf1; u32x4 kd; const u32x4 kk = rk[k];
                kd.x = pg8::cvt_pk_bf16(__uint_as_float(kk.x << 16) * f, __uint_as_float(kk.x & 0xffff0000u) * f); kd.y = pg8::cvt_pk_bf16(__uint_as_float(kk.y << 16) * f, __uint_as_float(kk.y & 0xffff0000u) * f);
                kd.z = pg8::cvt_pk_bf16(__uint_as_float(kk.z << 16) * f, __uint_as_float(kk.z & 0xffff0000u) * f); kd.w = pg8::cvt_pk_bf16(__uint_as_float(kk.w << 16) * f, __uint_as_float(kk.w & 0xffff0000u) * f);
                *(LAS u32x4*)(KD + row * QS + ch * 16) = kd; }
#pragma unroll
            for (int k = 0; k < 4; ++k) { const int p = tid + 512 * k, row = p >> 5, ch = p & 31; *(LAS u32x4*)(VI + row * VS + ch * 16) = rv[k]; }
            __syncthreads();
            if (n + 1 < nf) RET_LOADKV(n + 1);
            bf16x8 bV[4];
#pragma unroll
            for (int s = 0; s < 4; ++s) { const LAS unsigned char* p = VI + (16 * s + 8 * hf + trq) * VS + (32 * w + 16 * trblk + 4 * trp) * 2; bV[s] = cat8(lds_tr16(p), lds_tr16(p + 4 * VS)); }
#pragma unroll
            for (int dt = 0; dt < 4; ++dt) {
#pragma unroll
                for (int r = 0; r < 16; ++r) S[dt][r] *= g64;
#pragma unroll
                for (int s = 0; s < 4; ++s) { const LAS unsigned char* p = KD + (16 * s + 8 * hf + trq) * QS + (32 * dt + 16 * trblk + 4 * trp) * 2;
                    S[dt] = __builtin_amdgcn_mfma_f32_32x32x16_bf16(cat8(lds_tr16(p), lds_tr16(p + 4 * QS)), bV[s], S[dt], 0, 0, 0); }
            }
            __syncthreads();
        }
#undef RET_LOADKV
    }
    RET_LOAD(nf);
    for (int n = nf; n < n1; ++n) {
        constexpr bool full = true;
#pragma unroll
        for (int k = 0; k < 2; ++k) { const int p = tid + 512 * k, row = p >> 4, ch = p & 15;
            *(LAS u32x4*)(QI + row * QS + ch * 16) = rq[k]; *(LAS u32x4*)(KI + row * QS + ch * 16) = rk[k];
            const float f = k == 0 ? kf0 : kf1; u32x4 kd; const u32x4 kk = rk[k];
            kd.x = pg8::cvt_pk_bf16(__uint_as_float(kk.x << 16) * f, __uint_as_float(kk.x & 0xffff0000u) * f); kd.y = pg8::cvt_pk_bf16(__uint_as_float(kk.y << 16) * f, __uint_as_float(kk.y & 0xffff0000u) * f);
            kd.z = pg8::cvt_pk_bf16(__uint_as_float(kk.z << 16) * f, __uint_as_float(kk.z & 0xffff0000u) * f); kd.w = pg8::cvt_pk_bf16(__uint_as_float(kk.w << 16) * f, __uint_as_float(kk.w & 0xffff0000u) * f);
            *(LAS u32x4*)(KD + row * QS + ch * 16) = kd; }
#pragma unroll
        for (int k = 0; k < 4; ++k) { const int p = tid + 512 * k, row = p >> 5, ch = p & 31; *(LAS u32x4*)(VI + row * VS + ch * 16) = rv[k]; }
        __syncthreads();
        if (n + 1 < n1) RET_LOAD(n + 1);
        bf16x8 bV[4];
#pragma unroll
        for (int s = 0; s < 4; ++s) { const LAS unsigned char* p = VI + (16 * s + 8 * hf + trq) * VS + (32 * w + 16 * trblk + 4 * trp) * 2;
            bV[s] = cat8(lds_tr16(p), lds_tr16(p + 4 * VS)); }
        if (full && w < 4) { const int jt = w & 1, it = w >> 1; f32x16 X;
#pragma unroll
            for (int r = 0; r < 16; ++r) X[r] = 0.f;
#pragma unroll
            for (int s = 0; s < 8; ++s) { const bf16x8 a = *(const LAS bf16x8*)(KI + (32 * jt + c) * QS + (16 * s + 8 * hf) * 2), bq = *(const LAS bf16x8*)(QI + (32 * it + c) * QS + (16 * s + 8 * hf) * 2);
                X = __builtin_amdgcn_mfma_f32_32x32x16_bf16(a, bq, X, 0, 0, 0); }
#pragma unroll
            for (int g4 = 0; g4 < 4; ++g4) { f32x4 v;
#pragma unroll
                for (int k = 0; k < 4; ++k) { const int i = 32 * it + c, j = 32 * jt + 8 * g4 + 4 * hf + k; const int dist = i > j ? i - j : j - i; v[k] = X[4 * g4 + k] * __builtin_amdgcn_exp2f(lg2 * (float)dist); }
                { const uint2 pk = pg8::pack4(v); u32x2 pw; pw.x = pk.x; pw.y = pk.y; *(LAS u32x2*)(PI + (32 * it + c) * PS + (32 * jt + 8 * g4 + 4 * hf) * 2) = pw; } }
        }
        f32x16 Y[2];
#pragma unroll
        for (int it = 0; it < 2; ++it)
#pragma unroll
            for (int r = 0; r < 16; ++r) Y[it][r] = 0.f;
        if (full) {
#pragma unroll
        for (int dt = 0; dt < 4; ++dt)
#pragma unroll
            for (int sp = 0; sp < 2; ++sp) {
                u32x4 sw; sw.x = pg8::cvt_pk_bf16(S[dt][8 * sp + 0], S[dt][8 * sp + 1]); sw.y = pg8::cvt_pk_bf16(S[dt][8 * sp + 2], S[dt][8 * sp + 3]); sw.z = pg8::cvt_pk_bf16(S[dt][8 * sp + 4], S[dt][8 * sp + 5]); sw.w = pg8::cvt_pk_bf16(S[dt][8 * sp + 6], S[dt][8 * sp + 7]);
                const bf16x8 bS = __builtin_bit_cast(bf16x8, sw);
#pragma unroll
                for (int it = 0; it < 2; ++it) { const LAS unsigned char* p = QI + (32 * it + c) * QS + (32 * dt + 16 * sp + 4 * hf) * 2;
                    const u32x2 lo = *(const LAS u32x2*)p, hi = *(const LAS u32x2*)(p + 16); u32x4 aw; aw.x = lo.x; aw.y = lo.y; aw.z = hi.x; aw.w = hi.y;
                    Y[it] = __builtin_amdgcn_mfma_f32_32x32x16_bf16(__builtin_bit_cast(bf16x8, aw), bS, Y[it], 0, 0, 0); }
            }
#pragma unroll
        for (int it = 0; it < 2; ++it)
#pragma unroll
            for (int r = 0; r < 16; ++r) Y[it][r] *= __builtin_amdgcn_exp2f(lg2 * (float)(32 * it + crow16(r, hf) + 1));
        __syncthreads();
#pragma unroll
        for (int it = 0; it < 2; ++it)
#pragma unroll
            for (int s = 0; s < 4; ++s) { const bf16x8 a = *(const LAS bf16x8*)(PI + (32 * it + c) * PS + (16 * s + 8 * hf) * 2); Y[it] = __builtin_amdgcn_mfma_f32_32x32x16_bf16(a, bV[s], Y[it], 0, 0, 0); }
        }
#pragma unroll
        for (int dt = 0; dt < 4; ++dt) {
#pragma unroll
            for (int r = 0; r < 16; ++r) S[dt][r] *= g64;
#pragma unroll
            for (int s = 0; s < 4; ++s) { const LAS unsigned char* p = KD + (16 * s + 8 * hf + trq) * QS + (32 * dt + 16 * trblk + 4 * trp) * 2;
                S[dt] = __builtin_amdgcn_mfma_f32_32x32x16_bf16(cat8(lds_tr16(p), lds_tr16(p + 4 * QS)), bV[s], S[dt], 0, 0, 0); }
        }
        __syncthreads();
        if (full) {
        {
            const bf16_t* gp = YB + (tb0 + 64 * n + (tid >> 3)) * 1536 + 512 + h * 256 + (tid & 7) * 32;
#pragma unroll
            for (int k = 0; k < 4; ++k) rg[k] = *(const u32x4*)(gp + 8 * k);
        }
#pragma unroll
        for (int it = 0; it < 2; ++it)
#pragma unroll
            for (int r = 0; r < 16; ++r) YBUF[(32 * it + crow16(r, hf)) * YSF + 32 * w + c] = Y[it][r];
        __syncthreads();
        {
            const int i = tid >> 3, seg = tid & 7; const LAS f32x4* yp = (const LAS f32x4*)(YBUF + i * YSF + seg * 32);
            f32x4 y[8]; float s1 = 0.f;
#pragma unroll
            for (int k = 0; k < 8; ++k) { y[k] = yp[k]; s1 += (y[k][0] + y[k][1]) + (y[k][2] + y[k][3]); }
            s1 += __shfl_xor(s1, 1); s1 += __shfl_xor(s1, 2); s1 += __shfl_xor(s1, 4);
            const float mean = s1 * (1.f / 256.f); float s2 = 0.f;
#pragma unroll
            for (int k = 0; k < 8; ++k) { y[k] = y[k] - mean; s2 += (y[k][0] * y[k][0] + y[k][1] * y[k][1]) + (y[k][2] * y[k][2] + y[k][3] * y[k][3]); }
            s2 += __shfl_xor(s2, 1); s2 += __shfl_xor(s2, 2); s2 += __shfl_xor(s2, 4);
            const float rstd = rsqrtf(s2 * (1.f / 256.f) + GN_EPS);
            bf16_t* op = YB + (tb0 + 64 * n + i) * 1536 + 512 + h * 256 + seg * 32;
#pragma unroll
            for (int k = 0; k < 4; ++k) { const u32x4 gq = rg[k]; const f32x4 ya = y[2 * k] * rstd, yb2 = y[2 * k + 1] * rstd; u32x4 o;
                o.x = pg8::cvt_pk_bf16(ya[0] * __uint_as_float(gq.x << 16), ya[1] * __uint_as_float(gq.x & 0xffff0000u)); o.y = pg8::cvt_pk_bf16(ya[2] * __uint_as_float(gq.y << 16), ya[3] * __uint_as_float(gq.y & 0xffff0000u));
                o.z = pg8::cvt_pk_bf16(yb2[0] * __uint_as_float(gq.z << 16), yb2[1] * __uint_as_float(gq.z & 0xffff0000u)); o.w = pg8::cvt_pk_bf16(yb2[2] * __uint_as_float(gq.w << 16), yb2[3] * __uint_as_float(gq.w & 0xffff0000u));
                if (do_store) *(u32x4*)(op + 8 * k) = o; else asm volatile("" :: "v"(o.x), "v"(o.y), "v"(o.z), "v"(o.w)); }
        }
        __syncthreads();
        }
    }
#undef RET_LOAD
}

constexpr int NWAVES = 8, RING_BYTES = 131072, MISC_OFF = RING_BYTES + 320, LDS_BYTES = 147456;
constexpr int CW_Q = 64;
constexpr int CW_BAR = 4096;
struct Args {
    const float* in[21]; float* out; unsigned char* ws; int ph_lo, ph_hi, li, pad;
};
__global__ void __launch_bounds__(NWAVES * 64, 2) mk_fwd(Args args) {
    extern __shared__ __attribute__((aligned(16))) unsigned char lds_raw[];
    LAS unsigned char* lds = (LAS unsigned char*)lds_raw;
    volatile LAS unsigned* MISC = (volatile LAS unsigned*)(lds + MISC_OFF);
    const int wv = __builtin_amdgcn_readfirstlane(threadIdx.x >> 6);
#define TID_NOW() (wv * 64 + lane_now())
    const int G = gridDim.x;
    unsigned char* ws = args.ws;
    for (int u = TID_NOW(); u < (LDS_BYTES - RING_BYTES) / 4; u += NWAVES * 64) ((LAS unsigned*)(lds + RING_BYTES))[u] = 0u;
    __syncthreads();
    XcdBarrier bar = xcd_barrier_post((unsigned*)(ws + WS_CTL) + CW_BAR + args.li * XCD_BAR_WORDS, MISC + 8, TID_NOW());
    const int lo = args.ph_lo, hi = args.ph_hi;
#define IN(k) (lo <= (k) && (k) < hi)
#define BOTH(k) (IN(k) && IN((k) + 1))
#define WSP(T, off) ((T*)(ws + (off)))
    float* H = args.out;
    pg8::UEpi E{}; E.mid_t = -1; E.sc = 1.f; E.rs_tab = (const LAS float*)(lds + RING_BYTES + 1024);
    for (int rep_ = 0; rep_ < (PROBE_REP == 0 ? 2 : 1); ++rep_) if (IN(0)) { const int tid = TID_NOW();
        const int lane = tid & 63, wave = tid >> 6, gw = blockIdx.x * NWAVES + wave, NGW = G * NWAVES;
        LAS float* scr = (LAS float*)(lds + wave * 16384);
        const float* const* in = args.in;
        constexpr int I_GU = (D / 64) * (2 * FF / 32), I_D = (FF / 64) * (D / 32), I_WIN = (D / 64) * (4352 / 32), I_GATE = (D / 64) * (2048 / 32), I_A = (512 / 64) * (D / 32), I_SQ = (D / 64) * (D / 32), I_PP = (256 / 64) * (D / 32);
        constexpr int NITEMS = 2 * I_GU + 2 * I_D + I_WIN + I_GATE + I_A + 3 * I_SQ + I_PP;
        for (int it = gw; it < NITEMS; it += NGW) {
            int r = it;
            if (r < I_GU) { p0_item(SrcGU{in[4], in[5], in[3]}, WSP(bf16_t, WS_WGU1), 1024, 2 * FF, scr, r, lane); continue; } r -= I_GU;
            if (r < I_GU) { p0_item(SrcGU{in[14], in[15], in[13]}, WSP(bf16_t, WS_WGU2), 1024, 2 * FF, scr, r, lane); continue; } r -= I_GU;
            if (r < I_D) { p0_item(SrcPlain{in[6], nullptr, 1024, 1.f}, WSP(bf16_t, WS_WD1), FF, D, scr, r, lane); continue; } r -= I_D;
            if (r < I_D) { p0_item(SrcPlain{in[16], nullptr, 1024, 1.f}, WSP(bf16_t, WS_WD2), FF, D, scr, r, lane); continue; } r -= I_D;
            if (r < I_WIN) { p0_item(SrcWin{in[8], in[7]}, WSP(bf16_t, WS_WIN), 1024, 4352, scr, r, lane); continue; } r -= I_WIN;
            if (r < I_GATE) { p0_item(SrcPlain{in[8] + 4296, in[7], INW, 1.f}, WSP(bf16_t, WS_WGATE), 1024, 2048, scr, r, lane); continue; } r -= I_GATE;
            if (r < I_A) { p0_item(SrcPlain{in[10], nullptr, 1024, 1.f}, WSP(bf16_t, WS_WAB), 1536, D, scr, r, lane); continue; } r -= I_A;
            if (r < I_SQ) { p0_item(SrcPlain{in[11], in[9], 1024, 1.f}, WSP(bf16_t, WS_WAB) + 512, 1536, D, scr, r, lane); continue; } r -= I_SQ;
            if (r < I_SQ) { p0_item(SrcPlain{in[12], nullptr, 1024, 1.f}, WSP(bf16_t, WS_WOUT), 1024, D, scr, r, lane); continue; } r -= I_SQ;
            if (r < I_SQ) { p0_item(SrcPlain{in[18], in[17], 1024, 1.f}, WSP(bf16_t, WS_WPG), 1024, D, scr, r, lane); continue; } r -= I_SQ;
            p0_item(SrcPlain{in[19], nullptr, 1024, 1.f}, WSP(bf16_t, WS_WPP), 256, D, scr, r, lane);
        }
        const float* x = in[0]; bf16_t* hb = WSP(bf16_t, WS_HB); float* ss0 = WSP(float, WS_SS0);
        for (int row = gw; row < M; row += NGW) {
            const f32x4* xr = (const f32x4*)(x + (size_t)row * D) + lane; uint2* o8 = (uint2*)(hb + (size_t)row * D) + lane; float s = 0.f;
#pragma unroll
            for (int j = 0; j < 4; ++j) { const f32x4 v = xr[64 * j]; o8[64 * j] = pg8::pack4(v); s += (v[0] * v[0] + v[1] * v[1]) + (v[2] * v[2] + v[3] * v[3]); }
            s = wave_sum(s);
            if (lane < 16) ss0[(size_t)row * 16 + lane] = lane == 0 ? s : 0.f;
        }
        const float* p = in[1]; bf16_t* pb = WSP(bf16_t, WS_PB);
        for (size_t i = ((size_t)blockIdx.x * 512 + tid) * 4; i < (size_t)M * 256; i += (size_t)G * 512 * 4) *(uint2*)(pb + i) = pg8::pack4(*(const f32x4*)(p + i));
        const int* pos = (const int*)in[2]; float* cs64 = WSP(float, WS_CS64); float* cs32 = WSP(float, WS_CS32);
        __syncthreads();
        LAS float* invt = (LAS float*)lds;
        if (tid < 64) invt[tid] = powf(10000.f, -(float)tid / 64.f);
        __syncthreads();
        for (int i = blockIdx.x * 512 + tid; i < M * 64; i += G * 512) { const int tok = i >> 6, k = i & 63;
            const float ang = (float)pos[tok] * invt[k]; float sn, c; sincosf(ang, &sn, &c);
            cs64[(size_t)tok * 128 + k] = c; cs64[(size_t)tok * 128 + 64 + k] = sn;
            if ((k & 1) == 0) { cs32[(size_t)tok * 64 + (k >> 1)] = c; cs32[(size_t)tok * 64 + 32 + (k >> 1)] = sn; } }
        if (BOTH(0)) xcd_barrier(bar, tid);
    }
    for (int rep_ = 0; rep_ < (PROBE_REP == 1 ? 2 : 1); ++rep_) if (IN(1)) { const int tid = TID_NOW(); pg8::Gemm g{WSP(bf16_t, WS_HB), WSP(bf16_t, WS_WGU1), M, 2 * FF, D}; pg8::StaticOrder S; S.init(M, 2 * FF, G, (int)blockIdx.x);
        pg8::UEpi e = E; e.kind = pg8::EK_GU; e.ss = WSP(float, WS_SS0); e.o = WSP(bf16_t, WS_HID);
        pg8::gemm_phase<false>(lds, g, S, e, tid); if (BOTH(1)) xcd_barrier(bar, tid); }
    for (int rep_ = 0; rep_ < (PROBE_REP == 2 ? 2 : 1); ++rep_) if (IN(2)) { const int tid = TID_NOW(); pg8::Gemm g{WSP(bf16_t, WS_HID), WSP(bf16_t, WS_WD1), M, D, FF}; pg8::StaticOrder S; S.init(M, D, G, (int)blockIdx.x);
        pg8::UEpi e = E; e.kind = pg8::EK_RES; e.hb = WSP(bf16_t, WS_HB); e.sc = 0.5f; e.ssout = WSP(float, WS_SS1);
        pg8::gemm_phase<false>(lds, g, S, e, tid); if (BOTH(2)) xcd_barrier(bar, tid); }
    for (int rep_ = 0; rep_ < (PROBE_REP == 3 ? 2 : 1); ++rep_) if (IN(3)) { const int tid = TID_NOW(); pg8::Gemm g{WSP(bf16_t, WS_HB), WSP(bf16_t, WS_WIN), M, 4352, D}; pg8::StaticOrder S; S.init(M, 4352, G, (int)blockIdx.x);
        pg8::UEpi e = E; e.kind = pg8::EK_WIN; e.ss = WSP(float, WS_SS1); e.cs64 = WSP(float, WS_CS64); e.cs32 = WSP(float, WS_CS32);
        e.yb = WSP(bf16_t, WS_YB); e.ak = WSP(bf16_t, WS_AK); e.av = WSP(bf16_t, WS_AV); e.avt = WSP(bf16_t, WS_AVT); e.iq = WSP(bf16_t, WS_IQ); e.ik = WSP(bf16_t, WS_IK);
        e.rq = WSP(bf16_t, WS_RQ); e.rk = WSP(bf16_t, WS_RK); e.rv = WSP(bf16_t, WS_RV); e.iw = WSP(float, WS_IW);
        pg8::gemm_phase<false>(lds, g, S, e, tid); if (BOTH(3)) xcd_barrier(bar, tid); }
    for (int rep_ = 0; rep_ < ((PROBE_REP == 4 || (PROBE_REP >= 41 && PROBE_REP <= 44)) ? 2 : 1); ++rep_) if (IN(4)) { const int tid = TID_NOW();
        const bool st_ = !((PROBE_REP == 4 || (PROBE_REP >= 41 && PROBE_REP <= 44)) && rep_ == 0);
        if (blockIdx.x < 128 && !(PROBE_REP >= 42 && PROBE_REP <= 44 && rep_ == 0)) { const int it_ = (int)blockIdx.x >> 1, pt_ = (int)blockIdx.x & 1;
            ret_item(lds, it_ >> 2, it_ & 3, WSP(bf16_t, WS_RQ), WSP(bf16_t, WS_RK), WSP(bf16_t, WS_RV), WSP(bf16_t, WS_YB), wv, pt_ ? 32 : 16, pt_ ? 16 : 0, st_); }
        __syncthreads();
        for (;;) {
            if (tid == 0) MISC[16] = atomicAdd((unsigned*)(ws + WS_CTL) + CW_Q + 64 * rep_, 1u);
            __syncthreads();
            const unsigned tk = MISC[16];
            __syncthreads();
            if (tk >= 1024u || (PROBE_REP == 41 && rep_ == 0)) break;
            dsa_unit(lds, (int)(tk & 15u), 63 - (int)(tk >> 4), WSP(bf16_t, WS_IQ), WSP(bf16_t, WS_IK), WSP(float, WS_IW), WSP(bf16_t, WS_YB), WSP(bf16_t, WS_AK), WSP(bf16_t, WS_AV), wv, st_);
        }
        if (BOTH(4)) xcd_barrier(bar, tid);
    }
    for (int rep_ = 0; rep_ < (PROBE_REP == 5 ? 2 : 1); ++rep_) if (IN(5)) { const int tid = TID_NOW();
        pg8::StaticOrder S; S.init(M, D, G, (int)blockIdx.x);
        { pg8::Gemm g{WSP(bf16_t, WS_HB), WSP(bf16_t, WS_WGATE), M, D, D};
          pg8::UEpi e = E; e.kind = pg8::EK_GATE; e.ss = WSP(float, WS_SS1); e.o = WSP(bf16_t, WS_GA); pg8::gemm_phase<false>(lds, g, S, e, tid); }
        { pg8::Gemm g{WSP(bf16_t, WS_HB), WSP(bf16_t, WS_WGATE) + (size_t)D * D, M, D, D};
          pg8::UEpi e = E; e.kind = pg8::EK_GATE; e.ss = WSP(float, WS_SS1); e.o = WSP(bf16_t, WS_GB); pg8::gemm_phase<false>(lds, g, S, e, tid); }
        { pg8::Gemm g{WSP(bf16_t, WS_YB), WSP(bf16_t, WS_WAB), M, D, 1536};
          pg8::UEpi e = E; e.kind = pg8::EK_BR; e.mid_t = 8; e.ga = WSP(bf16_t, WS_GA); e.gb = WSP(bf16_t, WS_GB); e.o = WSP(bf16_t, WS_MERGED); pg8::gemm_phase<true>(lds, g, S, e, tid); }
        if (BOTH(5)) xcd_barrier(bar, tid); }
    for (int rep_ = 0; rep_ < (PROBE_REP == 6 ? 2 : 1); ++rep_) if (IN(6)) { const int tid = TID_NOW(); pg8::Gemm g{WSP(bf16_t, WS_MERGED), WSP(bf16_t, WS_WOUT), M, D, D}; pg8::StaticOrder S; S.init(M, D, G, (int)blockIdx.x);
        pg8::UEpi e = E; e.kind = pg8::EK_RES; e.hb = WSP(bf16_t, WS_HB); e.sc = 1.f; e.ssout = WSP(float, WS_SS0);
        pg8::gemm_phase<false>(lds, g, S, e, tid); if (BOTH(6)) xcd_barrier(bar, tid); }
    for (int rep_ = 0; rep_ < (PROBE_REP == 7 ? 2 : 1); ++rep_) if (IN(7)) { const int tid = TID_NOW(); pg8::Gemm g{WSP(bf16_t, WS_HB), WSP(bf16_t, WS_WGU2), M, 2 * FF, D}; pg8::StaticOrder S; S.init(M, 2 * FF, G, (int)blockIdx.x);
        pg8::UEpi e = E; e.kind = pg8::EK_GU; e.ss = WSP(float, WS_SS0); e.o = WSP(bf16_t, WS_HID);
        pg8::gemm_phase<false>(lds, g, S, e, tid); if (BOTH(7)) xcd_barrier(bar, tid); }
    for (int rep_ = 0; rep_ < (PROBE_REP == 8 ? 2 : 1); ++rep_) if (IN(8)) { const int tid = TID_NOW(); pg8::Gemm g{WSP(bf16_t, WS_HID), WSP(bf16_t, WS_WD2), M, D, FF}; pg8::StaticOrder S; S.init(M, D, G, (int)blockIdx.x);
        pg8::UEpi e = E; e.kind = pg8::EK_RES; e.hb = WSP(bf16_t, WS_HB); e.sc = 0.5f; e.ssout = WSP(float, WS_SS1);
        pg8::gemm_phase<false>(lds, g, S, e, tid); if (BOTH(8)) xcd_barrier(bar, tid); }
    for (int rep_ = 0; rep_ < (PROBE_REP == 9 ? 2 : 1); ++rep_) if (IN(9)) { const int tid = TID_NOW();
        pg8::StaticOrder S; S.init(M, D, G, (int)blockIdx.x);
        { pg8::Gemm g{WSP(bf16_t, WS_PB), WSP(bf16_t, WS_WPP), M, D, 256};
          pg8::UEpi e = E; e.kind = pg8::EK_PP; e.ppb = WSP(bf16_t, WS_PP); pg8::gemm_phase<false>(lds, g, S, e, tid); }
        { pg8::Gemm g{WSP(bf16_t, WS_HB), WSP(bf16_t, WS_WPG), M, D, D};
          pg8::UEpi e = E; e.kind = pg8::EK_PLE; e.ss = WSP(float, WS_SS1); e.hb = WSP(bf16_t, WS_HB); e.ppb = WSP(bf16_t, WS_PP); e.h4b = WSP(bf16_t, WS_H4B); e.ssout = WSP(float, WS_SS0); pg8::gemm_phase<false>(lds, g, S, e, tid); }
        if (BOTH(9)) xcd_barrier(bar, tid); }
    for (int rep_ = 0; rep_ < (PROBE_REP == 10 ? 2 : 1); ++rep_) if (IN(10)) { const int tid = TID_NOW();
        const int lane = tid & 63, gw = blockIdx.x * NWAVES + (tid >> 6), NGW = G * NWAVES;
        const float* gf = args.in[20]; const float* ss = WSP(float, WS_SS0);
        const bf16_t* h4 = WSP(bf16_t, WS_H4B);
        for (int row = gw; row < M; row += NGW) { const float rs = row_rstd(ss, row);
#pragma unroll
            for (int j = 0; j < 4; ++j) { const f32x4 hv = pg8::unpack4(*((const uint2*)(h4 + (size_t)row * D) + lane + 64 * j)); const f32x4 gg = *((const f32x4*)gf + lane + 64 * j);
                *((f32x4*)(H + (size_t)row * D) + lane + 64 * j) = hv * gg * rs; } }
    }
#undef IN
#undef BOTH
#undef WSP
}

extern "C" void kernel_launch(void* const* d_in, const int* in_sizes, int n_in, void* d_out, int out_size, void* d_ws, size_t ws_size, hipStream_t stream) {
    if (n_in != 21 || out_size != M * D || ws_size < WS_END) { fprintf(stderr, "kernel_launch: unexpected shapes (n_in %d out %d ws %zu)\n", n_in, out_size, ws_size); return; }
    static int grid = 0;
    if (grid == 0) {
        int dev = 0, cus = 0;
        if (hipGetDevice(&dev) != hipSuccess || hipDeviceGetAttribute(&cus, hipDeviceAttributeMultiprocessorCount, dev) != hipSuccess) { grid = -1; return; }
        if (hipFuncSetAttribute((const void*)mk_fwd, hipFuncAttributeMaxDynamicSharedMemorySize, LDS_BYTES) != hipSuccess) { fprintf(stderr, "hipFuncSetAttribute failed\n"); grid = -1; return; }
        grid = cus;
    }
    if (grid < 0) return;
    const float* x = (const float*)d_in[0]; const float* p = (const float*)d_in[1]; const int* pos = (const int*)d_in[2];
    const float* g1 = (const float*)d_in[3]; const float* wg1 = (const float*)d_in[4]; const float* wu1 = (const float*)d_in[5]; const float* wd1 = (const float*)d_in[6];
    const float* gmix = (const float*)d_in[7]; const float* win = (const float*)d_in[8]; const float* retgn = (const float*)d_in[9];
    const float* wba = (const float*)d_in[10]; const float* wbb = (const float*)d_in[11]; const float* wout = (const float*)d_in[12];
    const float* g2 = (const float*)d_in[13]; const float* wg2 = (const float*)d_in[14]; const float* wu2 = (const float*)d_in[15]; const float* wd2 = (const float*)d_in[16];
    const float* gple = (const float*)d_in[17]; const float* wpg = (const float*)d_in[18]; const float* wpp = (const float*)d_in[19];
    unsigned char* ws = (unsigned char*)d_ws;
#define WSP(T, off) ((T*)(ws + (off)))
    bf16_t *WGU1 = WSP(bf16_t, WS_WGU1), *WD1 = WSP(bf16_t, WS_WD1), *WIN = WSP(bf16_t, WS_WIN), *WGATE = WSP(bf16_t, WS_WGATE), *WAB = WSP(bf16_t, WS_WAB), *WOUT = WSP(bf16_t, WS_WOUT);
    bf16_t *WGU2 = WSP(bf16_t, WS_WGU2), *WD2 = WSP(bf16_t, WS_WD2), *WPG = WSP(bf16_t, WS_WPG), *WPP = WSP(bf16_t, WS_WPP);
    float *CS64 = WSP(float, WS_CS64), *CS32 = WSP(float, WS_CS32), *SS0 = WSP(float, WS_SS0);
    bf16_t *HB = WSP(bf16_t, WS_HB), *PB = WSP(bf16_t, WS_PB), *IQ = WSP(bf16_t, WS_IQ), *RQ = WSP(bf16_t, WS_RQ), *RK = WSP(bf16_t, WS_RK);
    bf16_t *AK = WSP(bf16_t, WS_AK), *AV = WSP(bf16_t, WS_AV), *IK = WSP(bf16_t, WS_IK);
    bf16_t *YB = WSP(bf16_t, WS_YB), *RV = WSP(bf16_t, WS_RV);
    float *IW = WSP(float, WS_IW); unsigned* MASK = WSP(unsigned, WS_MASK);
    if (hipMemsetAsync(ws + WS_CTL, 0, 256 * 1024, stream) != hipSuccess) { fprintf(stderr, "memset failed\n"); return; }
    Args a{};
    for (int i = 0; i < 21; ++i) a.in[i] = (const float*)d_in[i];
    a.out = (float*)d_out; a.ws = ws;
    a.ph_lo = 0; a.ph_hi = 11; a.li = 0;
    hipLaunchKernelGGL(mk_fwd, dim3(grid), dim3(NWAVES * 64), LDS_BYTES, stream, a);
#undef WSP
}
```
